# Optimizing an MI355X kernel written in HIP

```python
import numpy as np
import jax
import jax.numpy as jnp
from jax import lax

D_MODEL = 2048
BATCH = 4
SEQ = 8192
DEPTH = 1

MEM_LEN = 256
EPS = 1e-6
NEG = -1e30
BIG = 1e30
NSA_HEADS = 8
NSA_KV_HEADS = 2
NSA_GROUP = NSA_HEADS // NSA_KV_HEADS
NSA_DK = 128
NSA_DV = 128
CMP_LEN = 32
CMP_STRIDE = 16
CMP_HIDDEN = 256
SEL_BLOCK = 64
SEL_TOP = 16
WINDOW = 512
NSA_QBLOCK = 64
GLA_HEADS = 4
GLA_DK = 128
GLA_DV = 256
GLA_GATE_RANK = 16
GLA_GATE_NORM = 16.0
GLA_CHUNK = 64
D_MIX = NSA_HEADS * NSA_DV + GLA_HEADS * GLA_DV
MEM_HEADS = 4
MEM_DH = 128
D_FF = -(-8 * D_MODEL // (3 * 256)) * 256
IN_SIZES = (
    NSA_HEADS * NSA_DK,
    NSA_KV_HEADS * NSA_DK, NSA_KV_HEADS * NSA_DV,
    NSA_KV_HEADS * NSA_DK, NSA_KV_HEADS * NSA_DV,
    NSA_KV_HEADS * NSA_DK, NSA_KV_HEADS * NSA_DV,
    3 * NSA_HEADS,
    GLA_HEADS * GLA_DK, GLA_HEADS * GLA_DK,
    GLA_HEADS * GLA_DV,
    GLA_GATE_RANK,
    GLA_HEADS * GLA_DV,
)
D_IN = sum(IN_SIZES)

kernel_name = 'hymba_nsa_gla_alibi_memory_block'


def rms_norm(u, g):
    uf = u.astype(jnp.float32)
    y = uf * lax.rsqrt(jnp.mean(uf * uf, axis=-1, keepdims=True) + EPS)
    return (y * g.astype(jnp.float32)).astype(u.dtype)


def alibi_slopes(n):
    return jnp.exp2(-8.0 * jnp.arange(1, n + 1, dtype=jnp.float32) / n)


def split_points():
    return np.cumsum(np.array(IN_SIZES))[:-1].tolist()


def nsa_mixer(q, k_cmp, v_cmp, k_slc, v_slc, k_win, v_win, gates,
              g_q, g_kc, g_ks, g_kw, pe_k, pe_v, w_ck1, w_ck2, w_cv1, w_cv2):
    f32 = jnp.float32
    B, T = q.shape[0], q.shape[1]
    HKV, G, QB = NSA_KV_HEADS, NSA_GROUP, NSA_QBLOCK
    n_cmp = (T - CMP_LEN) // CMP_STRIDE + 1
    n_sel = T // SEL_BLOCK
    n_top = min(SEL_TOP, n_sel)
    n_qb = T // QB
    ratio = SEL_BLOCK // CMP_STRIDE
    lead = CMP_LEN // CMP_STRIDE - 1

    tok = jnp.arange(n_cmp)[:, None] * CMP_STRIDE + jnp.arange(CMP_LEN)[None, :]

    def compress(u, pe, w1, w2):
        blk = u[:, tok] + pe[None, None, :, None, :]
        blk = blk.transpose(0, 1, 3, 2, 4).reshape(B, n_cmp, HKV, -1)
        return (jax.nn.silu(blk @ w1) @ w2).transpose(0, 2, 1, 3)

    kc = rms_norm(compress(k_cmp, pe_k, w_ck1, w_ck2), g_kc)
    vc = compress(v_cmp, pe_v, w_cv1, w_cv2)
    cmp_end = jnp.arange(n_cmp) * CMP_STRIDE + (CMP_LEN - 1)
    cmp_mid = jnp.arange(n_cmp).astype(f32) * CMP_STRIDE + 0.5 * (CMP_LEN - 1)

    r = np.arange(ratio + lead)
    st = CMP_STRIDE * (r - lead)
    ov = jnp.asarray((np.minimum(st + CMP_LEN, SEL_BLOCK) - np.maximum(st, 0)) / CMP_STRIDE, f32)
    sel_idx = jnp.arange(n_sel)[:, None] * ratio + jnp.asarray(r)[None, :]

    ksb = rms_norm(k_slc, g_ks).reshape(B, n_sel, SEL_BLOCK, HKV, NSA_DK).transpose(0, 3, 1, 2, 4)
    vsb = v_slc.reshape(B, n_sel, SEL_BLOCK, HKV, NSA_DV).transpose(0, 3, 1, 2, 4)
    pad_t = ((0, 0), (0, 0), (WINDOW, 0), (0, 0))
    kwp = jnp.pad(rms_norm(k_win, g_kw).transpose(0, 2, 1, 3), pad_t)
    vwp = jnp.pad(v_win.transpose(0, 2, 1, 3), pad_t)

    slopes = alibi_slopes(NSA_HEADS).reshape(HKV, G)
    sl5 = slopes[None, :, :, None, None]
    sl6 = slopes[None, :, :, None, None, None]
    jb = jnp.arange(n_sel)
    bi = jnp.arange(B)[:, None, None, None]
    hi = jnp.arange(HKV)[None, :, None, None]

    qn = rms_norm(q, g_q) * (NSA_DK ** -0.5)
    qs = qn.reshape(B, n_qb, QB, HKV, G, NSA_DK).transpose(1, 0, 3, 4, 2, 5)
    gs = gates.reshape(B, n_qb, QB, HKV, G, 3).transpose(1, 0, 3, 4, 2, 5)

    def block(args):
        c, qb, gb = args
        t = c * QB + jnp.arange(QB)
        s = jnp.einsum('bkgtd,bknd->bkgtn', qb, kc).astype(f32)
        vis = t[:, None] >= cmp_end[None, :]
        s = jnp.where(vis, s - sl5 * (t[:, None].astype(f32) - cmp_mid[None, :]), NEG)
        p = jax.nn.softmax(s, axis=-1)
        p = jnp.where(jnp.any(vis, axis=-1)[:, None], p, 0.0)
        o_cmp = jnp.einsum('bkgtn,bknd->bkgtd', p.astype(vc.dtype), vc)
        imp = jnp.pad(p.sum(2), ((0, 0), (0, 0), (0, 0), (lead, lead)))
        imp = jnp.einsum('bktjr,r->bktj', imp[..., sel_idx], ov)
        cur = (t // SEL_BLOCK)[:, None]
        forced = (jb == 0) | (jb == cur) | (jb == cur - 1)
        score = jnp.where(forced, BIG, jnp.where(jb <= cur, imp, NEG))
        top_s, top_i = lax.top_k(score, n_top)
        ks_g = ksb[bi, hi, top_i]
        vs_g = vsb[bi, hi, top_i]
        pos = top_i[..., None] * SEL_BLOCK + jnp.arange(SEL_BLOCK)
        tt = t[:, None, None]
        ok = (top_s > 0.5 * NEG)[..., None] & (pos <= tt)
        s = jnp.einsum('bkgtd,bktnsd->bkgtns', qb, ks_g).astype(f32)
        s = jnp.where(ok[:, :, None], s - sl6 * (tt - pos).astype(f32)[:, :, None], NEG)
        p = jax.nn.softmax(s.reshape(s.shape[:4] + (-1,)), axis=-1).reshape(s.shape)
        o_slc = jnp.einsum('bkgtns,bktnsd->bkgtd', p.astype(vs_g.dtype), vs_g)
        kw = lax.dynamic_slice_in_dim(kwp, c * QB, QB + WINDOW, axis=2)
        vw = lax.dynamic_slice_in_dim(vwp, c * QB, QB + WINDOW, axis=2)
        pos_w = c * QB - WINDOW + jnp.arange(QB + WINDOW)
        dw = t[:, None] - pos_w[None, :]
        okw = (dw >= 0) & (dw < WINDOW) & (pos_w >= 0)[None, :]
        s = jnp.einsum('bkgtd,bksd->bkgts', qb, kw).astype(f32)
        s = jnp.where(okw, s - sl5 * dw.astype(f32), NEG)
        p = jax.nn.softmax(s, axis=-1)
        o_win = jnp.einsum('bkgts,bksd->bkgtd', p.astype(vw.dtype), vw)
        return gb[..., 0:1] * o_cmp + gb[..., 1:2] * o_slc + gb[..., 2:3] * o_win

    out = lax.map(block, (jnp.arange(n_qb), qs, gs))
    return out.transpose(1, 0, 4, 2, 3, 5).reshape(B, T, NSA_HEADS, NSA_DV)


def gla_mixer(q, k, v, log_a):
    B, T, H, DK = q.shape
    DV = v.shape[-1]
    C = GLA_CHUNK
    n = T // C

    def chunks(u):
        return u.astype(jnp.float32).reshape(B, n, C, H, -1).transpose(1, 0, 3, 2, 4)

    causal = jnp.tril(jnp.ones((C, C), bool))[:, :, None]

    def step(S, inp):
        qc, kc, vc, ac = inp
        b = jnp.cumsum(ac, axis=2)
        decay = jnp.exp(jnp.where(causal, b[:, :, :, None, :] - b[:, :, None, :, :], -jnp.inf))
        attn = jnp.einsum('bhid,bhjd,bhijd->bhij', qc, kc, decay)
        o = (jnp.einsum('bhij,bhjv->bhiv', attn, vc)
             + jnp.einsum('bhid,bhdv->bhiv', qc * jnp.exp(b), S))
        b_end = b[:, :, -1:, :]
        S = (S * jnp.exp(b_end[:, :, 0, :, None])
             + jnp.einsum('bhjd,bhjv->bhdv', kc * jnp.exp(b_end - b), vc))
        return S, o

    S0 = jnp.zeros((B, H, DK, DV), jnp.float32)
    _, o = lax.scan(step, S0, (chunks(q), chunks(k), chunks(v), chunks(log_a)))
    return o.transpose(1, 0, 3, 2, 4).reshape(B, T, H, DV)


def hybrid_layer(x, mem, g_mix, w_in, b_nsa_gate, g_q, g_kc, g_ks, g_kw, pe_k, pe_v,
                 w_ck1, w_ck2, w_cv1, w_cv2, g_nsa_out, w_gk2, b_gk, g_gla_out, w_out,
                 g_cross, g_mem, w_cq, w_ck, w_cv, g_cq, g_ck, w_co, g_ffn, w_gu, w_down):
    B, T, _ = x.shape
    M = mem.shape[1]
    h = rms_norm(x, g_mix)
    (q, k_c, v_c, k_s, v_s, k_w, v_w, g_logit,
     q_l, k_l, v_l, a_l, r_l) = jnp.split(h @ w_in, split_points(), axis=-1)

    def heads(u, nh):
        return u.reshape(B, T, nh, -1)

    hkv = NSA_KV_HEADS
    gates = jax.nn.sigmoid(g_logit + b_nsa_gate).reshape(B, T, NSA_HEADS, 3)
    o_nsa = nsa_mixer(heads(q, NSA_HEADS), heads(k_c, hkv), heads(v_c, hkv), heads(k_s, hkv),
                      heads(v_s, hkv), heads(k_w, hkv), heads(v_w, hkv), gates,
                      g_q, g_kc, g_ks, g_kw, pe_k, pe_v, w_ck1, w_ck2, w_cv1, w_cv2)
    o_nsa = rms_norm(o_nsa, g_nsa_out).reshape(B, T, -1)

    log_a = jax.nn.log_sigmoid((a_l @ w_gk2 + b_gk).astype(jnp.float32)) / GLA_GATE_NORM
    o_gla = gla_mixer(heads(q_l, GLA_HEADS) * (GLA_DK ** -0.5), heads(k_l, GLA_HEADS),
                      heads(v_l, GLA_HEADS), heads(log_a, GLA_HEADS))
    o_gla = rms_norm(o_gla, g_gla_out).astype(x.dtype).reshape(B, T, -1) * jax.nn.silu(r_l)
    x = x + jnp.concatenate([o_nsa, o_gla], axis=-1) @ w_out

    hq = rms_norm(x, g_cross)
    hm = rms_norm(mem, g_mem)
    cq = rms_norm((hq @ w_cq).reshape(B, T, MEM_HEADS, MEM_DH), g_cq) * (MEM_DH ** -0.5)
    ck = rms_norm((hm @ w_ck).reshape(B, M, MEM_HEADS, MEM_DH), g_ck)
    cv = (hm @ w_cv).reshape(B, M, MEM_HEADS, MEM_DH)
    s = jnp.einsum('bthd,bmhd->bhtm', cq, ck).astype(jnp.float32)
    p = jax.nn.softmax(s, axis=-1).astype(cv.dtype)
    x = x + jnp.einsum('bhtm,bmhd->bthd', p, cv).reshape(B, T, -1) @ w_co

    hf = rms_norm(x, g_ffn)
    gg, uu = jnp.split(hf @ w_gu, 2, axis=-1)
    return x + (jax.nn.silu(gg) * uu) @ w_down


def setup_inputs(seed: int = 0) -> dict:
    key = jax.random.key(seed)
    keys = iter(jax.random.split(key, 40))
    L = DEPTH

    def nrm(shape, scale):
        return scale * jax.random.normal(next(keys), shape, jnp.float32)

    def gain(n):
        return 1.0 + nrm((L, n), 0.05)

    return {
        'x': nrm((BATCH, SEQ, D_MODEL), 1.0),
        'mem': nrm((BATCH, MEM_LEN, D_MODEL), 1.0),
        'g_mix': gain(D_MODEL),
        'w_in': nrm((L, D_MODEL, D_IN), D_MODEL ** -0.5),
        'b_nsa_gate': nrm((L, 3 * NSA_HEADS), 0.1),
        'g_q': gain(NSA_DK),
        'g_kc': gain(NSA_DK),
        'g_ks': gain(NSA_DK),
        'g_kw': gain(NSA_DK),
        'pe_k': nrm((L, CMP_LEN, NSA_DK), 0.5),
        'pe_v': nrm((L, CMP_LEN, NSA_DV), 0.5),
        'w_ck1': nrm((L, CMP_LEN * NSA_DK, CMP_HIDDEN), (CMP_LEN * NSA_DK) ** -0.5),
        'w_ck2': nrm((L, CMP_HIDDEN, NSA_DK), CMP_HIDDEN ** -0.5),
        'w_cv1': nrm((L, CMP_LEN * NSA_DV, CMP_HIDDEN), (CMP_LEN * NSA_DV) ** -0.5),
        'w_cv2': nrm((L, CMP_HIDDEN, NSA_DV), CMP_HIDDEN ** -0.5),
        'g_nsa_out': gain(NSA_DV),
        'w_gk2': nrm((L, GLA_GATE_RANK, GLA_HEADS * GLA_DK), GLA_GATE_RANK ** -0.5),
        'b_gk': nrm((L, GLA_HEADS * GLA_DK), 0.1),
        'g_gla_out': gain(GLA_DV),
        'w_out': nrm((L, D_MIX, D_MODEL), D_MIX ** -0.5),
        'g_cross': gain(D_MODEL),
        'g_mem': gain(D_MODEL),
        'w_cq': nrm((L, D_MODEL, MEM_HEADS * MEM_DH), D_MODEL ** -0.5),
        'w_ck': nrm((L, D_MODEL, MEM_HEADS * MEM_DH), D_MODEL ** -0.5),
        'w_cv': nrm((L, D_MODEL, MEM_HEADS * MEM_DH), D_MODEL ** -0.5),
        'g_cq': gain(MEM_DH),
        'g_ck': gain(MEM_DH),
        'w_co': nrm((L, MEM_HEADS * MEM_DH, D_MODEL), (MEM_HEADS * MEM_DH) ** -0.5),
        'g_ffn': gain(D_MODEL),
        'w_gu': nrm((L, D_MODEL, 2 * D_FF), D_MODEL ** -0.5),
        'w_down': nrm((L, D_FF, D_MODEL), D_FF ** -0.5),
    }


def reference(x, mem, g_mix, w_in, b_nsa_gate, g_q, g_kc, g_ks, g_kw, pe_k, pe_v,
              w_ck1, w_ck2, w_cv1, w_cv2, g_nsa_out, w_gk2, b_gk, g_gla_out, w_out,
              g_cross, g_mem, w_cq, w_ck, w_cv, g_cq, g_ck, w_co, g_ffn, w_gu, w_down):
    for l in range(DEPTH):
        x = hybrid_layer(x, mem, g_mix[l], w_in[l], b_nsa_gate[l], g_q[l], g_kc[l], g_ks[l],
                         g_kw[l], pe_k[l], pe_v[l], w_ck1[l], w_ck2[l], w_cv1[l], w_cv2[l],
                         g_nsa_out[l], w_gk2[l], b_gk[l], g_gla_out[l], w_out[l],
                         g_cross[l], g_mem[l], w_cq[l], w_ck[l], w_cv[l], g_cq[l], g_ck[l],
                         w_co[l], g_ffn[l], w_gu[l], w_down[l])
    return x
```

```cpp
#include <hip/hip_runtime.h>
#include <hip/hip_cooperative_groups.h>
#include <cstdio>
#include <cstdint>
namespace cg = cooperative_groups;
namespace pg8 {
#define PG8_LAS __attribute__((address_space(3)))
typedef unsigned short bf16_t;
typedef short bf16x8 __attribute__((ext_vector_type(8)));
typedef float f32x4 __attribute__((ext_vector_type(4)));
typedef unsigned u32x4 __attribute__((ext_vector_type(4)));
constexpr int BM = 256, BK = 64, HALF = 128, HTB = HALF * BK * 2  , STAGE_BYTES = 8 * HTB, NXCD = 8, WGM = 8;

__host__ __device__ __forceinline__ int lds_byte(int r, int c) { const int st = (r >> 4) * 2 + (c >> 5), rr = r & 15, cc = c & 31, ob = rr * 64 + cc * 2; return st * 1024 + (ob ^ (((ob >> 9) & 1) << 5)); }
__host__ __device__ __forceinline__ void stage_rc(int b, int& R, int& C) { const int st = b / 1024, sb = b % 1024, swz = sb ^ (((sb >> 9) & 1) << 5); R = (st >> 1) * 16 + swz / 64; C = (st & 1) * 32 + (swz % 64) / 2; }
__host__ __device__ __forceinline__ int perm32(int rho) { const int n = rho >> 4, i = rho & 15; return 8 * (i >> 2) + 4 * n + (i & 3); }

struct Unit { int pm, pn; };
struct Gemm { const bf16_t* A; const bf16_t* Bt; int M, N, K; };

struct StaticOrder {
    int nM, nN, nwg, G, c;
    __host__ __device__ void init(int M, int N, int G_, int c_) { nM = M / BM; nN = N / BM; nwg = nM * nN; G = G_; c = c_; }
    __host__ __device__ bool next(int i, Unit& u) const {
        const long L = (long)i * G + c; if (L >= nwg) return false;
        int wgid = (int)L; { const int q = nwg / NXCD, r = nwg % NXCD, xcd = wgid % NXCD, off = wgid / NXCD; wgid = (xcd < r ? xcd * (q + 1) : r * (q + 1) + (xcd - r) * q) + off; }
        const int nig = WGM * nN, gid = wgid / nig, fm = gid * WGM, gsz = (nM - fm) < WGM ? (nM - fm) : WGM;
        u.pm = fm + ((wgid % nig) % gsz); u.pn = (wgid % nig) / gsz; return true;
    }
    __device__ __forceinline__ void a_ready(const Unit&) const {}
    __device__ __forceinline__ void done(const Unit&) const {}
};

__device__ __forceinline__ unsigned cvt_pk_bf16(float lo, float hi) { unsigned r; asm volatile("v_cvt_pk_bf16_f32 %0, %1, %2" : "=v"(r) : "v"(lo), "v"(hi)); return r; }
typedef float f32x2 __attribute__((ext_vector_type(2)));
typedef float f32x2_t __attribute__((ext_vector_type(2))); typedef __bf16 bf16x2_t __attribute__((ext_vector_type(2)));
__device__ __forceinline__ unsigned cvtpk(float lo, float hi) { f32x2_t v = {lo, hi}; bf16x2_t b = __builtin_convertvector(v, bf16x2_t); return __builtin_bit_cast(unsigned, b); }
struct EpiBf16 {
    static constexpr bool PERM = true, AFTER_DRAIN = false;
    bf16_t* O; int ldc; const float* ss;
    __device__ __forceinline__ void operator()(const f32x4 (&acc)[2][2][4][2], const Unit& u, int wr, int wc, int fr, int fq) const {
        const int row0 = u.pm * BM + wr * 64 + fr; const int col0 = u.pn * BM + wc * 32 + 8 * fq;
        float rsv[2][4];
#pragma unroll
        for (int ai = 0; ai < 2; ++ai)
#pragma unroll
            for (int m = 0; m < 4; ++m) rsv[ai][m] = ss ? ss[row0 + ai * HALF + m * 16] : 0.f;
        __builtin_amdgcn_sched_barrier(0);
#pragma unroll
        for (int ai = 0; ai < 2; ++ai)
#pragma unroll
            for (int m = 0; m < 4; ++m) { const int row = row0 + ai * HALF + m * 16; bf16_t* rowp = O + (size_t)row * ldc + col0;
                const float rs = ss ? __builtin_amdgcn_rsqf(rsv[ai][m] * (1.f / 2048.f) + 1e-6f) : 1.f;
#pragma unroll
                for (int bj = 0; bj < 2; ++bj) { const f32x4 v0 = acc[ai][bj][m][0] * rs, v1 = acc[ai][bj][m][1] * rs;
                    u32x4 w; w.x = cvtpk(v0[0], v0[1]); w.y = cvtpk(v0[2], v0[3]); w.z = cvtpk(v1[0], v1[1]); w.w = cvtpk(v1[2], v1[3]);
                    *(u32x4*)(rowp + bj * HALF) = w; } }
    }
};
struct EpiResF32 {
    static constexpr bool PERM = false, AFTER_DRAIN = false;
    const float* base; float* out; int ldc;
    __device__ __forceinline__ void operator()(const f32x4 (&acc)[2][2][4][2], const Unit& u, int wr, int wc, int fr, int fq) const {
        const int col0 = u.pn * BM + wc * 32 + 4 * fq;
#pragma unroll
        for (int ai = 0; ai < 2; ++ai)
#pragma unroll
            for (int m = 0; m < 4; ++m) { const size_t off = (size_t)(u.pm * BM + ai * HALF + wr * 64 + m * 16 + fr) * ldc + col0;
#pragma unroll
                for (int bj = 0; bj < 2; ++bj)
#pragma unroll
                    for (int n = 0; n < 2; ++n) { const size_t p = off + bj * HALF + n * 16; const f32x4 b = *(const f32x4*)(base + p); *(f32x4*)(out + p) = b + acc[ai][bj][m][n]; } }
    }
};
struct EpiSwiGLU {
    static constexpr bool PERM = true, AFTER_DRAIN = false;
    bf16_t* O; int ldc; const float* ss;
    static __device__ __forceinline__ float sw(float g, float u) { return g * __builtin_amdgcn_rcpf(1.0f + __expf(-g)) * u; }
    __device__ __forceinline__ void operator()(const f32x4 (&acc)[2][2][4][2], const Unit& u, int wr, int wc, int fr, int fq) const {
        const int row0 = u.pm * BM + wr * 64 + fr; const int col0 = u.pn * HALF + wc * 32 + 8 * fq;
        float rsv[2][4];
#pragma unroll
        for (int ai = 0; ai < 2; ++ai)
#pragma unroll
            for (int m = 0; m < 4; ++m) rsv[ai][m] = ss[row0 + ai * HALF + m * 16];
        __builtin_amdgcn_sched_barrier(0);
#pragma unroll
        for (int ai = 0; ai < 2; ++ai)
#pragma unroll
            for (int m = 0; m < 4; ++m) { const int row = row0 + ai * HALF + m * 16; bf16_t* rowp = O + (size_t)row * ldc + col0;
                const float rs = __builtin_amdgcn_rsqf(rsv[ai][m] * (1.f / 2048.f) + 1e-6f);
                const f32x4 g0 = acc[ai][0][m][0] * rs, g1 = acc[ai][0][m][1] * rs, u0 = acc[ai][1][m][0] * rs, u1 = acc[ai][1][m][1] * rs;
                u32x4 w; w.x = cvtpk(sw(g0[0], u0[0]), sw(g0[1], u0[1])); w.y = cvtpk(sw(g0[2], u0[2]), sw(g0[3], u0[3]));
                w.z = cvtpk(sw(g1[0], u1[0]), sw(g1[1], u1[1])); w.w = cvtpk(sw(g1[2], u1[2]), sw(g1[3], u1[3]));
                *(u32x4*)rowp = w; }
    }
};

__device__ __forceinline__ float bfl(unsigned w) { return __uint_as_float(w << 16); }
__device__ __forceinline__ float bfh(unsigned w) { return __uint_as_float(w & 0xffff0000u); }
template <bool BASE_F32> struct EpiResSS {
    static constexpr bool PERM = true, AFTER_DRAIN = false;
    const void* base; bf16_t* XB; float* ss; int ldc;
    __device__ __forceinline__ void operator()(const f32x4 (&acc)[2][2][4][2], const Unit& u, int wr, int wc, int fr, int fq) const {
        const int row0 = u.pm * BM + wr * 64 + fr; const int col0 = u.pn * BM + wc * 32 + 8 * fq;
#pragma unroll
        for (int ai = 0; ai < 2; ++ai) {
            f32x4 pb0[4][2], pb1[4][2]; u32x4 pw[4][2];
#pragma unroll
            for (int m = 0; m < 4; ++m)
#pragma unroll
                for (int bj = 0; bj < 2; ++bj) { const size_t off = (size_t)(row0 + ai * HALF + m * 16) * ldc + col0 + bj * HALF;
                    if (BASE_F32) { pb0[m][bj] = __builtin_nontemporal_load((const f32x4*)((const float*)base + off)); pb1[m][bj] = __builtin_nontemporal_load((const f32x4*)((const float*)base + off + 4)); }
                    else pw[m][bj] = *(const u32x4*)((const bf16_t*)base + off); }
            __builtin_amdgcn_sched_barrier(0);
#pragma unroll
            for (int m = 0; m < 4; ++m) { const int row = row0 + ai * HALF + m * 16; float sq = 0.f;
#pragma unroll
                for (int bj = 0; bj < 2; ++bj) { const size_t off = (size_t)row * ldc + col0 + bj * HALF; f32x4 b0, b1;
                    if (BASE_F32) { b0 = pb0[m][bj]; b1 = pb1[m][bj]; }
                    else { const u32x4 w = pw[m][bj]; b0 = (f32x4){bfl(w.x), bfh(w.x), bfl(w.y), bfh(w.y)}; b1 = (f32x4){bfl(w.z), bfh(w.z), bfl(w.w), bfh(w.w)}; }
                    const f32x4 v0 = b0 + acc[ai][bj][m][0], v1 = b1 + acc[ai][bj][m][1];
                    u32x4 o; o.x = cvtpk(v0[0], v0[1]); o.y = cvtpk(v0[2], v0[3]); o.z = cvtpk(v1[0], v1[1]); o.w = cvtpk(v1[2], v1[3]);
                    *(u32x4*)(XB + off) = o;
                    sq += (bfl(o.x) * bfl(o.x) + bfh(o.x) * bfh(o.x)) + (bfl(o.y) * bfl(o.y) + bfh(o.y) * bfh(o.y)) + (bfl(o.z) * bfl(o.z) + bfh(o.z) * bfh(o.z)) + (bfl(o.w) * bfl(o.w) + bfh(o.w) * bfh(o.w)); }
                sq += __shfl_xor(sq, 16); sq += __shfl_xor(sq, 32);
                if (fq == 0) atomicAdd(ss + row, sq); }
            __builtin_amdgcn_sched_barrier(0);
        }
    }
};
struct EpiOutF32 {
    static constexpr bool PERM = true, AFTER_DRAIN = false;
    const bf16_t* XB; float* out; int ldc;
    __device__ __forceinline__ void operator()(const f32x4 (&acc)[2][2][4][2], const Unit& u, int wr, int wc, int fr, int fq) const {
        const int row0 = u.pm * BM + wr * 64 + fr; const int col0 = u.pn * BM + wc * 32 + 8 * fq;
#pragma unroll
        for (int ai = 0; ai < 2; ++ai) {
            u32x4 pw[4][2];
#pragma unroll
            for (int m = 0; m < 4; ++m)
#pragma unroll
                for (int bj = 0; bj < 2; ++bj) pw[m][bj] = *(const u32x4*)(XB + (size_t)(row0 + ai * HALF + m * 16) * ldc + col0 + bj * HALF);
            __builtin_amdgcn_sched_barrier(0);
#pragma unroll
            for (int m = 0; m < 4; ++m)
#pragma unroll
                for (int bj = 0; bj < 2; ++bj) { const size_t off = (size_t)(row0 + ai * HALF + m * 16) * ldc + col0 + bj * HALF;
                    const u32x4 w = pw[m][bj];
                    __builtin_nontemporal_store((f32x4){bfl(w.x), bfh(w.x), bfl(w.y), bfh(w.y)} + acc[ai][bj][m][0], (f32x4*)(out + off));
                    __builtin_nontemporal_store((f32x4){bfl(w.z), bfh(w.z), bfl(w.w), bfh(w.w)} + acc[ai][bj][m][1], (f32x4*)(out + off + 4)); }
            __builtin_amdgcn_sched_barrier(0);
        }
    }
};
template <class Epi, class Sched, bool ALIGN_EPI = false, bool SP2 = false>
__device__ __forceinline__ void gemm_phase(PG8_LAS unsigned char* lds, const Gemm g, const Sched& S, const Epi& E, const int tid_in) {
    const int tid = tid_in, wid = __builtin_amdgcn_readfirstlane(tid >> 6), lane = tid & 63, wr = wid >> 2, wc = wid & 3, fr = lane & 15, fq = lane >> 4;
    const int K = g.K, nt = K / BK;
    unsigned voffA[2], voffB[2];
#pragma unroll
    for (int i = 0; i < 2; ++i) { int R, C; stage_rc(tid * 16 + i * 8192, R, C); const int Rb = Epi::PERM ? ((R & ~31) + perm32(R & 31)) : R;
        voffA[i] = (unsigned)(R * K + C) * 2u; voffB[i] = (unsigned)(Rb * K + C) * 2u; }
    const size_t kstep = (size_t)(BK * 2);
    const size_t hstep = (size_t)HALF * K * 2;
    const size_t tstep = 2 * hstep;
    const unsigned ldsw = (unsigned)wid * 1024u;
    const int aoff = lds_byte(wr * 64 + fr, fq * 8), boff = lds_byte(wc * 32 + fr, fq * 8);
#define PG8_SA(b, h) (((b) * 2 + (h)) * HTB)
#define PG8_SB(b, h) ((4 + (b) * 2 + (h)) * HTB)
#define PG8_STAGE(bufoff, gbase, voff) do { _Pragma("unroll") for (int _i = 0; _i < 2; ++_i) \
        __builtin_amdgcn_global_load_lds((const unsigned*)((const char*)(gbase) + (voff)[_i]), (PG8_LAS unsigned*)(lds + (bufoff) + ldsw + _i * 8192), 16, 0, 0); } while (0)
#define PG8_LDA(dst, b, h) do { _Pragma("unroll") for (int m = 0; m < 4; ++m) _Pragma("unroll") for (int k = 0; k < 2; ++k) dst[m][k] = *(const PG8_LAS bf16x8*)(lds + PG8_SA(b, h) + aoff + m * 2048 + k * 1024); } while (0)
#define PG8_LDB(dst, b, h) do { _Pragma("unroll") for (int n = 0; n < 2; ++n) _Pragma("unroll") for (int k = 0; k < 2; ++k) dst[n][k] = *(const PG8_LAS bf16x8*)(lds + PG8_SB(b, h) + boff + n * 2048 + k * 1024); } while (0)
#define PG8_MMA(ai, bj, At, Bt) do { __builtin_amdgcn_s_setprio(1); _Pragma("unroll") for (int m = 0; m < 4; ++m) _Pragma("unroll") for (int n = 0; n < 2; ++n) _Pragma("unroll") for (int k = 0; k < 2; ++k) \
        acc[ai][bj][m][n] = __builtin_amdgcn_mfma_f32_16x16x32_bf16(Bt[n][k], At[m][k], acc[ai][bj][m][n], 0, 0, 0); __builtin_amdgcn_s_setprio(0); } while (0)
#define PG8_WAIT_V(n) asm volatile("s_waitcnt vmcnt(" #n ")" ::: "memory")
#define PG8_WAIT_L(n) asm volatile("s_waitcnt lgkmcnt(" #n ")" ::: "memory")
#define PG8_BAR __builtin_amdgcn_s_barrier()
#define PG8_SCHED __builtin_amdgcn_sched_barrier(0)
    Unit cur, nxt; int ui = 0;
    if (!S.next(0, cur)) return;
    f32x4 acc[2][2][4][2];
#pragma unroll
    for (int a = 0; a < 2; ++a)
#pragma unroll
        for (int b = 0; b < 2; ++b)
#pragma unroll
            for (int m = 0; m < 4; ++m)
#pragma unroll
                for (int n = 0; n < 2; ++n) acc[a][b][m][n] = (f32x4){0.f, 0.f, 0.f, 0.f};
    bf16x8 At[4][2], B0[2][2], B1[2][2];
    const char* cA = (const char*)g.A + (size_t)cur.pm * tstep; const char* cB = (const char*)g.Bt + (size_t)cur.pn * tstep;
    S.a_ready(cur);
    if constexpr (SP2) {
        PG8_STAGE(PG8_SB(0, 0), cB, voffB); PG8_STAGE(PG8_SB(0, 1), cB + hstep, voffB); PG8_STAGE(PG8_SA(0, 0), cA, voffA); PG8_STAGE(PG8_SA(0, 1), cA + hstep, voffA);
        if (wr == 1) PG8_BAR;
        PG8_WAIT_V(2); PG8_BAR;
        PG8_STAGE(PG8_SB(1, 0), cB + kstep, voffB); PG8_STAGE(PG8_SA(1, 0), cA + kstep, voffA); PG8_STAGE(PG8_SB(1, 1), cB + hstep + kstep, voffB);
        PG8_WAIT_V(6); PG8_BAR;
    } else {
        PG8_STAGE(PG8_SB(0, 0), cB, voffB); PG8_STAGE(PG8_SA(0, 0), cA, voffA); PG8_STAGE(PG8_SB(0, 1), cB + hstep, voffB); PG8_STAGE(PG8_SA(0, 1), cA + hstep, voffA);
        if (wr == 1) PG8_BAR;
        PG8_WAIT_V(4); PG8_BAR;
        PG8_STAGE(PG8_SB(1, 0), cB + kstep, voffB); PG8_STAGE(PG8_SA(1, 0), cA + kstep, voffA); PG8_STAGE(PG8_SB(1, 1), cB + hstep + kstep, voffB);
        PG8_WAIT_V(6); PG8_BAR;
    }
    for (;;) {
        const bool has_next = S.next(ui + 1, nxt);
        const char* nA = has_next ? (const char*)g.A + (size_t)nxt.pm * tstep : cA; const char* nB = has_next ? (const char*)g.Bt + (size_t)nxt.pn * tstep : cB;
        for (int t = 0; t < nt; t += 2) {
            const bool last = (t == nt - 2);
            const char* a1 = cA + (size_t)(t + 1) * kstep;
            const char* a2 = last ? nA : cA + (size_t)(t + 2) * kstep; const char* b2 = last ? nB : cB + (size_t)(t + 2) * kstep;
            const char* a3 = a2 + kstep; const char* b3 = b2 + kstep;
            if (last && has_next) S.a_ready(nxt);
            if constexpr (SP2) {
            PG8_LDB(B0, 0, 0); PG8_LDB(B1, 0, 1); PG8_SCHED; PG8_LDA(At, 0, 0); PG8_STAGE(PG8_SA(1, 1), a1 + hstep, voffA);
            PG8_WAIT_V(8); PG8_WAIT_L(0); PG8_BAR; PG8_MMA(0, 0, At, B0); PG8_MMA(0, 1, At, B1); PG8_BAR; PG8_SCHED;
            PG8_LDA(At, 0, 1); PG8_STAGE(PG8_SB(0, 0), b2, voffB); PG8_STAGE(PG8_SB(0, 1), b2 + hstep, voffB); PG8_STAGE(PG8_SA(0, 0), a2, voffA);
            PG8_WAIT_V(8); PG8_WAIT_L(0); PG8_BAR; PG8_MMA(1, 0, At, B0); PG8_MMA(1, 1, At, B1); PG8_BAR; PG8_SCHED;
            PG8_LDB(B0, 1, 0); PG8_LDB(B1, 1, 1); PG8_SCHED; PG8_LDA(At, 1, 0); PG8_STAGE(PG8_SA(0, 1), a2 + hstep, voffA);
            PG8_WAIT_V(8); PG8_WAIT_L(0); PG8_BAR; PG8_MMA(0, 0, At, B0); PG8_MMA(0, 1, At, B1); PG8_BAR; PG8_SCHED;
            PG8_LDA(At, 1, 1); PG8_STAGE(PG8_SB(1, 0), b3, voffB); PG8_STAGE(PG8_SB(1, 1), b3 + hstep, voffB); PG8_STAGE(PG8_SA(1, 0), a3, voffA);
            PG8_WAIT_V(8); PG8_WAIT_L(0); PG8_BAR; PG8_MMA(1, 0, At, B0); PG8_MMA(1, 1, At, B1); PG8_BAR; PG8_SCHED;
            } else {
            PG8_LDB(B0, 0, 0); PG8_SCHED; PG8_LDA(At, 0, 0); PG8_STAGE(PG8_SA(1, 1), a1 + hstep, voffA);
            PG8_WAIT_L(8); PG8_BAR; PG8_WAIT_L(0); PG8_MMA(0, 0, At, B0); PG8_BAR; PG8_SCHED;
            PG8_LDB(B1, 0, 1); PG8_STAGE(PG8_SB(0, 0), b2, voffB);
            PG8_BAR; PG8_WAIT_L(0); PG8_MMA(0, 1, At, B1); PG8_BAR;
            PG8_LDA(At, 0, 1); PG8_STAGE(PG8_SA(0, 0), a2, voffA);
            PG8_BAR; PG8_WAIT_L(0); PG8_MMA(1, 0, At, B0); PG8_BAR; PG8_SCHED;
            PG8_STAGE(PG8_SB(0, 1), b2 + hstep, voffB);
            PG8_WAIT_V(6); PG8_BAR; PG8_MMA(1, 1, At, B1); PG8_BAR;
            PG8_LDB(B0, 1, 0); PG8_SCHED; PG8_LDA(At, 1, 0); PG8_STAGE(PG8_SA(0, 1), a2 + hstep, voffA);
            PG8_WAIT_L(8); PG8_BAR; PG8_WAIT_L(0); PG8_MMA(0, 0, At, B0); PG8_BAR; PG8_SCHED;
            PG8_LDB(B1, 1, 1); PG8_STAGE(PG8_SB(1, 0), b3, voffB);
            PG8_BAR; PG8_WAIT_L(0); PG8_MMA(0, 1, At, B1); PG8_BAR;
            PG8_LDA(At, 1, 1); PG8_STAGE(PG8_SA(1, 0), a3, voffA);
            PG8_BAR; PG8_WAIT_L(0); PG8_MMA(1, 0, At, B0); PG8_BAR; PG8_SCHED;
            PG8_STAGE(PG8_SB(1, 1), b3 + hstep, voffB);
            PG8_WAIT_V(6); PG8_BAR; PG8_MMA(1, 1, At, B1); PG8_BAR;
            }
        }
        if constexpr (ALIGN_EPI) { if (wr == 0) PG8_BAR; }
        if constexpr (!Epi::AFTER_DRAIN) { E(acc, cur, wr, wc, fr, fq); S.done(cur); }
        if (!has_next) break;
#pragma unroll
        for (int a = 0; a < 2; ++a)
#pragma unroll
            for (int b = 0; b < 2; ++b)
#pragma unroll
                for (int m = 0; m < 4; ++m)
#pragma unroll
                    for (int n = 0; n < 2; ++n) acc[a][b][m][n] = (f32x4){0.f, 0.f, 0.f, 0.f};
        cur = nxt; cA = nA; cB = nB; ++ui;
        if constexpr (ALIGN_EPI) { if (wr == 1) PG8_BAR; }
    }
    PG8_WAIT_V(0);
    if constexpr (!ALIGN_EPI) { if (wr == 0) PG8_BAR; }
    PG8_BAR;
    if constexpr (Epi::AFTER_DRAIN) { E.fused(acc, cur, wr, wc, fr, fq, lds, wid, lane); S.done(cur); }
#undef PG8_SA
#undef PG8_SB
#undef PG8_STAGE
#undef PG8_LDA
#undef PG8_LDB
#undef PG8_MMA
#undef PG8_WAIT_V
#undef PG8_WAIT_L
#undef PG8_BAR
#undef PG8_SCHED
}
}
#define DI __device__ __forceinline__
#define LAS __attribute__((address_space(3)))
typedef unsigned short bf16;
typedef short bf16x8 __attribute__((ext_vector_type(8)));
typedef short s16x4 __attribute__((ext_vector_type(4)));
typedef float f32x4 __attribute__((ext_vector_type(4)));
typedef unsigned u32x4 __attribute__((ext_vector_type(4)));
typedef unsigned u32x2 __attribute__((ext_vector_type(2)));
constexpr int NWAVES = 8, NT = 512;
constexpr int Bn = 4, T = 8192, D = 2048, M = Bn * T;
constexpr int MEM = 256, MM = Bn * MEM;
constexpr int DIN = 5672, LDP = 5888;
constexpr int DFF = 5632;
constexpr float EPS = 1e-6f;
constexpr int C_Q = 0, C_KC = 1024, C_VC = 1280, C_KS = 1536, C_VS = 1792, C_KW = 2048, C_VW = 2304, C_GATE = 2560,
              C_QL = 2584, C_KL = 3096, C_VL = 3608, C_AL = 4632, C_RL = 4648;
constexpr int NCMP = 511, NSEL = 128;
constexpr size_t MiB = 1u << 20;
constexpr size_t WS_SS1 = 0, WS_SS2 = 262144, WS_BAR = 786432, WS_WT_IN = 1 * MiB, WS_WT_OUT = 25 * MiB, WS_WT_CQ = 33 * MiB, WS_WT_CKV = 35 * MiB, WS_WT_CO = 39 * MiB, WS_WT_GU = 41 * MiB,
                 WS_WT_DOWN = 85 * MiB, WS_WT_C1K = 107 * MiB, WS_WT_C1V = 109 * MiB, WS_WT_C2K = 111 * MiB, WS_WT_C2V = 111 * MiB + 65536,
                 WS_HM = 112 * MiB, WS_CKV = 116 * MiB, WS_CVT = 118 * MiB, WS_KC = 119 * MiB, WS_VCT = 120 * MiB, WS_GD = 121 * MiB,
                 WS_VST = 122 * MiB, WS_VWT = 138 * MiB, WS_CQ = 154 * MiB, WS_CO = 186 * MiB, WS_H = 218 * MiB, WS_MIX = 346 * MiB,
                 WS_UT = 474 * MiB, WS_PROJ = 602 * MiB, WS_HID = 602 * MiB, WS_NSAO = 970 * MiB, WS_END = 1002 * MiB;
constexpr int LDS_BYTES = 147456;

DI float bf2f(unsigned v) { return __uint_as_float(v << 16); }
DI float bflo(unsigned w) { return __uint_as_float(w << 16); }
DI float bfhi(unsigned w) { return __uint_as_float(w & 0xffff0000u); }
DI unsigned pk2(float lo, float hi) { return pg8::cvtpk(lo, hi); }
DI bf16 f2bf(float f) { return (bf16)(pg8::cvtpk(f, 0.f) & 0xffffu); }
DI float wave_sum(float v) {
#pragma unroll
    for (int o = 1; o < 64; o <<= 1) v += __shfl_xor(v, o);
    return v;
}
DI float silu_f(float g) { return g * __builtin_amdgcn_rcpf(1.0f + __expf(-g)); }
#define MFMA16(a, b, c) __builtin_amdgcn_mfma_f32_16x16x32_bf16((a), (b), (c), 0, 0, 0)

struct Frame {
    LAS unsigned char* lds;
    int tid, lane, wave, G, bid;
    const float* const* in;
};

DI void transpose_item(const float* W, int K, int Nsrc, bf16* WT, int dst_row0, int srcc0, int k0, LAS float* scr, int lane, const float* kg) {
#pragma unroll 8
    for (int i = 0; i < 32; ++i) { const int kk = 2 * i + (lane >> 5); const int sc = srcc0 + (lane & 31);
        scr[kk * 33 + (lane & 31)] = (sc < Nsrc) ? W[(size_t)(k0 + kk) * Nsrc + sc] * (kg ? kg[k0 + kk] : 1.f) : 0.f; }
    asm volatile("s_waitcnt lgkmcnt(0)" ::: "memory");
    const int c = lane & 7;
#pragma unroll
    for (int j = 0; j < 4; ++j) { const int n = (lane >> 3) + 8 * j; const LAS float* s = scr + (8 * c) * 33 + n;
        u32x4 o; o.x = pk2(s[0 * 33], s[1 * 33]); o.y = pk2(s[2 * 33], s[3 * 33]); o.z = pk2(s[4 * 33], s[5 * 33]); o.w = pk2(s[6 * 33], s[7 * 33]);
        *(u32x4*)(WT + (size_t)(dst_row0 + n) * K + k0 + 8 * c) = o; }
    asm volatile("s_waitcnt lgkmcnt(0)" ::: "memory");
}
DI bool transpose_mat(int& r, const float* W, int K, int Nsrc, int Ndst, bf16* WT, int row_off, int mode, LAS float* scr, int lane, const float* kg = nullptr) {
    const int nblk = Ndst / 32, items = (K / 64) * nblk;
    if (r >= items) { r -= items; return false; }
    const int kb = r / nblk, nb = r % nblk, n0 = 32 * nb;
    int sc = n0;
    if (mode == 1) sc = ((n0 & 255) >> 7) * DFF + (n0 >> 8) * 128 + (n0 & 127);
    transpose_item(W, K, Nsrc, WT, row_off + n0, sc, 64 * kb, scr, lane, kg);
    return true;
}
DI void rms_row_to_bf16(const float* xrow, const float* g, bf16* orow, int lane) {
    const f32x4* xr = (const f32x4*)xrow + lane; const f32x4* gr = (const f32x4*)g + lane;
    f32x4 v[8], gv[8]; float s = 0.f;
#pragma unroll
    for (int j = 0; j < 8; ++j) { v[j] = __builtin_nontemporal_load(xr + 64 * j); gv[j] = gr[64 * j]; }
    __builtin_amdgcn_sched_barrier(0);
#pragma unroll
    for (int j = 0; j < 8; ++j) s += (v[j].x * v[j].x + v[j].y * v[j].y) + (v[j].z * v[j].z + v[j].w * v[j].w);
    const float rstd = __builtin_amdgcn_rsqf(wave_sum(s) * (1.f / D) + EPS);
    u32x2* o8 = (u32x2*)orow + lane;
#pragma unroll
    for (int j = 0; j < 8; ++j) { const f32x4 gg = gv[j]; u32x2 w; w.x = pk2(v[j].x * rstd * gg.x, v[j].y * rstd * gg.y); w.y = pk2(v[j].z * rstd * gg.z, v[j].w * rstd * gg.w); o8[64 * j] = w; }
}
DI void rms_rows_phase(const Frame& F, const float* src, const float* g, bf16* dst, int nrows) {
    const int gw = F.bid * NWAVES + F.wave, NGW = F.G * NWAVES;
    for (int m = gw; m < nrows; m += NGW) rms_row_to_bf16(src + (size_t)m * D, g, dst + (size_t)m * D, F.lane);
}
DI void prep_item(const Frame& F, bf16* src, int ld, int rowbase, int kbase, int vbase, int kstep, const float* g0, const float* g1,
                  bf16* vd, size_t vstep1, size_t vstep2, int vld, int vcoff) {
    LAS bf16* Tt = (LAS bf16*)F.lds;
#pragma unroll
    for (int i = 0; i < 8; ++i) { const int idx = F.tid + NT * i, w = idx >> 10, row = (idx >> 4) & 63, ch = idx & 15;
        const u32x4 v = *(const u32x4*)(src + (size_t)(rowbase + row) * ld + vbase + (w >> 1) * kstep + (w & 1) * 128 + ch * 8);
        *(LAS u32x4*)(Tt + (w * 64 + row) * 136 + ch * 8) = v; }
    {
        unsigned uv[32];
        unsigned* pb = (unsigned*)(src + (size_t)(rowbase + F.wave * 8) * ld + kbase) + F.lane;
#pragma unroll
        for (int it = 0; it < 32; ++it) uv[it] = pb[((size_t)(it >> 2) * ld + ((it >> 1) & 1) * kstep + (it & 1) * 128) >> 1];
        const float ga0 = g0[2 * F.lane], ga1 = g0[2 * F.lane + 1], gb0 = g1[2 * F.lane], gb1 = g1[2 * F.lane + 1];
        __builtin_amdgcn_sched_barrier(0);
#pragma unroll
        for (int it = 0; it < 32; ++it) { const float a = bflo(uv[it]), b = bfhi(uv[it]);
            const float rstd = __builtin_amdgcn_rsqf(wave_sum(a * a + b * b) * (1.f / 128.f) + EPS);
            pb[((size_t)(it >> 2) * ld + ((it >> 1) & 1) * kstep + (it & 1) * 128) >> 1] = (it & 2) ? pk2(a * rstd * gb0, b * rstd * gb1) : pk2(a * rstd * ga0, b * rstd * ga1); }
    }
    __syncthreads();
#pragma unroll
    for (int i = 0; i < 8; ++i) { const int idx = F.tid + NT * i, w = idx >> 10, tch = (idx >> 7) & 7, dv = idx & 127;
        const LAS bf16* s = Tt + (w * 64 + tch * 8) * 136 + dv;
        u32x4 o; o.x = (unsigned)s[0] | ((unsigned)s[136] << 16); o.y = (unsigned)s[2 * 136] | ((unsigned)s[3 * 136] << 16);
        o.z = (unsigned)s[4 * 136] | ((unsigned)s[5 * 136] << 16); o.w = (unsigned)s[6 * 136] | ((unsigned)s[7 * 136] << 16);
        *(u32x4*)(vd + (w >> 1) * vstep2 + (w & 1) * vstep1 + (size_t)dv * vld + vcoff + tch * 8) = o; }
    __syncthreads();
}

DI void compress_item(const Frame& F, int item, const bf16* PROJ, const float* pe_k, const float* pe_v, const bf16* w1k, const bf16* w1v,
                      const bf16* w2k, const bf16* w2v, const float* g_kc, bf16* KC, bf16* VCT) {
    const int kv = item & 1, itile = (item >> 1) & 15, kvh = (item >> 5) & 1, b = item >> 6;
    const float* pe = kv ? pe_v : pe_k; const bf16* W1 = kv ? w1v : w1k; const bf16* W2 = kv ? w2v : w2k;
    const int cbase = (kv ? C_VC : C_KC) + kvh * 128;
    const int r = F.lane & 15, quad = F.lane >> 4;
    LAS bf16* Hs = (LAS bf16*)F.lds;
    LAS float* red = (LAS float*)(F.lds + 32 * 264 * 2);
    int I0 = itile * 32 + r, I1 = I0 + 16; if (I0 > 510) I0 = 510; if (I1 > 510) I1 = 510;
    const bf16* a0p = PROJ + (size_t)(b * T + 16 * I0) * LDP + cbase + quad * 8;
    const bf16* a1p = PROJ + (size_t)(b * T + 16 * I1) * LDP + cbase + quad * 8;
    const bf16* b0p = W1 + (size_t)(F.wave * 32 + r) * 4096 + quad * 8;
    const bf16* b1p = b0p + (size_t)16 * 4096;
    f32x4 acc[2][2];
#pragma unroll
    for (int i = 0; i < 2; ++i)
#pragma unroll
        for (int j = 0; j < 2; ++j) acc[i][j] = (f32x4){0.f, 0.f, 0.f, 0.f};
#pragma unroll 1
    for (int l = 0; l < 32; ++l) {
        f32x4 pv[4][2]; u32x4 xa[4], xb[4]; bf16x8 wa[4], wb[4];
#pragma unroll
        for (int q = 0; q < 4; ++q) {
            pv[q][0] = *(const f32x4*)(pe + l * 128 + q * 32 + quad * 8); pv[q][1] = *(const f32x4*)(pe + l * 128 + q * 32 + quad * 8 + 4);
            xa[q] = *(const u32x4*)(a0p + (size_t)l * LDP + q * 32); xb[q] = *(const u32x4*)(a1p + (size_t)l * LDP + q * 32);
            wa[q] = *(const bf16x8*)(b0p + (l * 4 + q) * 32); wb[q] = *(const bf16x8*)(b1p + (l * 4 + q) * 32); }
        __builtin_amdgcn_sched_barrier(0);
#pragma unroll
        for (int q = 0; q < 4; ++q) {
            const f32x4 p0 = pv[q][0], p1 = pv[q][1]; const u32x4 x0 = xa[q], x1 = xb[q];
            u32x4 y0, y1;
            y0.x = pk2(bflo(x0.x) + p0.x, bfhi(x0.x) + p0.y); y0.y = pk2(bflo(x0.y) + p0.z, bfhi(x0.y) + p0.w);
            y0.z = pk2(bflo(x0.z) + p1.x, bfhi(x0.z) + p1.y); y0.w = pk2(bflo(x0.w) + p1.z, bfhi(x0.w) + p1.w);
            y1.x = pk2(bflo(x1.x) + p0.x, bfhi(x1.x) + p0.y); y1.y = pk2(bflo(x1.y) + p0.z, bfhi(x1.y) + p0.w);
            y1.z = pk2(bflo(x1.z) + p1.x, bfhi(x1.z) + p1.y); y1.w = pk2(bflo(x1.w) + p1.z, bfhi(x1.w) + p1.w);
            const bf16x8 a0 = __builtin_bit_cast(bf16x8, y0), a1 = __builtin_bit_cast(bf16x8, y1);
            acc[0][0] = MFMA16(a0, wa[q], acc[0][0]); acc[0][1] = MFMA16(a0, wb[q], acc[0][1]);
            acc[1][0] = MFMA16(a1, wa[q], acc[1][0]); acc[1][1] = MFMA16(a1, wb[q], acc[1][1]);
        }
        __builtin_amdgcn_sched_barrier(0);
    }
#pragma unroll
    for (int mt = 0; mt < 2; ++mt)
#pragma unroll
        for (int nt = 0; nt < 2; ++nt)
#pragma unroll
            for (int j = 0; j < 4; ++j) Hs[(mt * 16 + quad * 4 + j) * 264 + F.wave * 32 + nt * 16 + r] = f2bf(silu_f(acc[mt][nt][j]));
    __syncthreads();
    f32x4 acc2[2] = {(f32x4){0.f, 0.f, 0.f, 0.f}, (f32x4){0.f, 0.f, 0.f, 0.f}};
#pragma unroll
    for (int ks = 0; ks < 8; ++ks) {
        const bf16x8 bb = *(const bf16x8*)(W2 + (size_t)(F.wave * 16 + r) * 256 + ks * 32 + quad * 8);
#pragma unroll
        for (int mt = 0; mt < 2; ++mt) { const bf16x8 a = *(const LAS bf16x8*)(Hs + (mt * 16 + r) * 264 + ks * 32 + quad * 8); acc2[mt] = MFMA16(a, bb, acc2[mt]); }
    }
#pragma unroll
    for (int mt = 0; mt < 2; ++mt)
#pragma unroll
        for (int j = 0; j < 4; ++j) { float s = acc2[mt][j] * acc2[mt][j];
            s += __shfl_xor(s, 1); s += __shfl_xor(s, 2); s += __shfl_xor(s, 4); s += __shfl_xor(s, 8);
            if (r == 0) red[(mt * 16 + quad * 4 + j) * 8 + F.wave] = s; }
    __syncthreads();
    const int col = F.wave * 16 + r; const float gk = g_kc[col];
#pragma unroll
    for (int mt = 0; mt < 2; ++mt)
#pragma unroll
        for (int j = 0; j < 4; ++j) { const int row = mt * 16 + quad * 4 + j, I = itile * 32 + row;
            float ss = 0.f;
#pragma unroll
            for (int w = 0; w < 8; ++w) ss += red[row * 8 + w];
            const float rstd = __builtin_amdgcn_rsqf(ss * (1.f / 128.f) + EPS);
            const bool valid = I < NCMP;
            if (kv == 0) KC[((size_t)(b * 2 + kvh) * 512 + I) * 128 + col] = valid ? f2bf(acc2[mt][j] * rstd * gk) : (bf16)0;
            else VCT[((size_t)(b * 2 + kvh) * 128 + col) * 512 + I] = valid ? f2bf(acc2[mt][j]) : (bf16)0; }
    __syncthreads();
}
DI void gla_chunk_b(const Frame& F, const bf16* PROJ, const float* w_gk2, const float* b_gk, int b, int h, int c, LAS float* LB, LAS float* As, LAS float* Ps) {
    const size_t row0 = (size_t)b * T + (size_t)c * 64;
    if (F.tid < 128) { const int j = F.tid >> 1, hh = F.tid & 1; const u32x4 x = *(const u32x4*)(PROJ + (row0 + j) * LDP + C_AL + hh * 8); LAS float* ap = As + j * 16 + hh * 8;
        ap[0] = bflo(x.x); ap[1] = bfhi(x.x); ap[2] = bflo(x.y); ap[3] = bfhi(x.y); ap[4] = bflo(x.z); ap[5] = bfhi(x.z); ap[6] = bflo(x.w); ap[7] = bfhi(x.w); }
    const int d = F.tid & 127, part = F.tid >> 7;
    float w[16];
#pragma unroll
    for (int rr = 0; rr < 16; ++rr) w[rr] = w_gk2[rr * 512 + h * 128 + d];
    const float bias = b_gk[h * 128 + d];
    __builtin_amdgcn_sched_barrier(0);
    __syncthreads();
    float run = 0.f;
#pragma unroll 4
    for (int jj = 0; jj < 16; ++jj) { const int j = part * 16 + jj; float x = bias;
#pragma unroll
        for (int rr = 0; rr < 16; ++rr) x += As[j * 16 + rr] * w[rr];
        const float la = (fminf(x, 0.f) - log1pf(__expf(-fabsf(x)))) * (1.f / 16.f);
        run += la; LB[j * 128 + d] = run; }
    Ps[part * 128 + d] = run;
    __syncthreads();
    float pre = 0.f;
#pragma unroll
    for (int p = 0; p < 3; ++p) if (p < part) pre += Ps[p * 128 + d];
#pragma unroll
    for (int jj = 0; jj < 16; ++jj) LB[(part * 16 + jj) * 128 + d] += pre;
    __syncthreads();
}
constexpr int GL_LB = 0, GL_AS = 32768, GL_PS = 36864, GL_X = 38912;
DI void gla_a_item(const Frame& F, int item, const bf16* PROJ, const float* w_gk2, const float* b_gk, bf16* UT, float* GD, bf16* QT, bf16* KT, bf16* VTG) {
    const int c = item & 127, h = (item >> 7) & 3, b = item >> 9;
    LAS float* LB = (LAS float*)(F.lds + GL_LB); LAS float* As = (LAS float*)(F.lds + GL_AS); LAS float* Ps = (LAS float*)(F.lds + GL_PS);
    LAS bf16* KH = (LAS bf16*)(F.lds + GL_X);
    LAS bf16* Vt = (LAS bf16*)(F.lds + GL_X + 18432);
    const size_t row0 = (size_t)b * T + (size_t)c * 64;
    const bf16* tp = PROJ + (row0 + (F.tid >> 3)) * LDP + (F.tid & 7) * 16;
    const u32x4 hk0 = *(const u32x4*)(tp + C_KL + h * 128), hk1 = *(const u32x4*)(tp + C_KL + h * 128 + 8);
    const u32x4 hq0 = *(const u32x4*)(tp + C_QL + h * 128), hq1 = *(const u32x4*)(tp + C_QL + h * 128 + 8);
    u32x4 hv[4];
#pragma unroll
    for (int q = 0; q < 4; ++q) hv[q] = *(const u32x4*)(tp + (F.tid & 7) * 16 + C_VL + h * 256 + q * 8);
    __builtin_amdgcn_sched_barrier(0);
    gla_chunk_b(F, PROJ, w_gk2, b_gk, b, h, c, LB, As, Ps);
    { const int j = F.tid >> 3, d0 = (F.tid & 7) * 16; const bf16* kp = PROJ + (row0 + j) * LDP + C_KL + h * 128 + d0;
      const u32x4 x0 = hk0, x1 = hk1;
      const unsigned xw[8] = {x0.x, x0.y, x0.z, x0.w, x1.x, x1.y, x1.z, x1.w};
#pragma unroll
      for (int q = 0; q < 8; ++q) { const int d = d0 + 2 * q;
          KH[d * 72 + j] = f2bf(bflo(xw[q]) * __expf(LB[63 * 128 + d] - LB[j * 128 + d]));
          KH[(d + 1) * 72 + j] = f2bf(bfhi(xw[q]) * __expf(LB[63 * 128 + d + 1] - LB[j * 128 + d + 1])); }
      if (F.tid < 128) GD[(size_t)item * 128 + F.tid] = __expf(LB[63 * 128 + F.tid]);
      const bf16* qp = PROJ + (row0 + j) * LDP + C_QL + h * 128 + d0;
      const u32x4 q0 = hq0, q1 = hq1;
      const unsigned qw[8] = {q0.x, q0.y, q0.z, q0.w, q1.x, q1.y, q1.z, q1.w};
      unsigned qo[8], ko[8];
#pragma unroll
      for (int q = 0; q < 8; ++q) { const float l0 = LB[j * 128 + d0 + 2 * q], l1 = LB[j * 128 + d0 + 2 * q + 1];
          qo[q] = pk2(bflo(qw[q]) * 0.08838834764831845f * __expf(l0), bfhi(qw[q]) * 0.08838834764831845f * __expf(l1));
          ko[q] = pk2(bflo(xw[q]) * __expf(-l0), bfhi(xw[q]) * __expf(-l1)); }
      bf16* qd = QT + ((size_t)item * 64 + j) * 128 + d0; bf16* kd = KT + ((size_t)item * 64 + j) * 128 + d0;
      *(u32x4*)qd = (u32x4){qo[0], qo[1], qo[2], qo[3]}; *(u32x4*)(qd + 8) = (u32x4){qo[4], qo[5], qo[6], qo[7]};
      *(u32x4*)kd = (u32x4){ko[0], ko[1], ko[2], ko[3]}; *(u32x4*)(kd + 8) = (u32x4){ko[4], ko[5], ko[6], ko[7]}; }
    { const int j = F.tid >> 3, dv0 = (F.tid & 7) * 32; const bf16* vp = PROJ + (row0 + j) * LDP + C_VL + h * 256 + dv0;
      u32x4 x[4];
#pragma unroll
      for (int q = 0; q < 4; ++q) x[q] = hv[q];
#pragma unroll
      for (int q = 0; q < 4; ++q) { LAS bf16* o = Vt + (dv0 + q * 8) * 72 + j;
          o[0] = (bf16)(x[q].x & 0xffffu); o[72] = (bf16)(x[q].x >> 16); o[2 * 72] = (bf16)(x[q].y & 0xffffu); o[3 * 72] = (bf16)(x[q].y >> 16);
          o[4 * 72] = (bf16)(x[q].z & 0xffffu); o[5 * 72] = (bf16)(x[q].z >> 16); o[6 * 72] = (bf16)(x[q].w & 0xffffu); o[7 * 72] = (bf16)(x[q].w >> 16); } }
    __syncthreads();
#pragma unroll
    for (int i = 0; i < 4; ++i) { const int idx = F.tid + NT * i, dv = idx >> 3, ch = idx & 7;
        *(u32x4*)(VTG + ((size_t)item * 256 + dv) * 64 + ch * 8) = *(const LAS u32x4*)(Vt + dv * 72 + ch * 8); }
    const int r = F.lane & 15, quad = F.lane >> 4;
#pragma unroll 1
    for (int hf = 0; hf < 2; ++hf) {
        f32x4 acc[8];
#pragma unroll
        for (int i = 0; i < 8; ++i) acc[i] = (f32x4){0.f, 0.f, 0.f, 0.f};
#pragma unroll
        for (int ks = 0; ks < 2; ++ks) { const bf16x8 a = *(const LAS bf16x8*)(KH + (F.wave * 16 + r) * 72 + ks * 32 + quad * 8);
#pragma unroll
            for (int nt = 0; nt < 8; ++nt) { const bf16x8 bb = *(const LAS bf16x8*)(Vt + ((hf * 8 + nt) * 16 + r) * 72 + ks * 32 + quad * 8); acc[nt] = MFMA16(a, bb, acc[nt]); } }
#pragma unroll
        for (int nt = 0; nt < 8; ++nt) { u32x2 o; o.x = pk2(acc[nt][0], acc[nt][1]); o.y = pk2(acc[nt][2], acc[nt][3]);
            *(u32x2*)(UT + ((size_t)item * 256 + (hf * 8 + nt) * 16 + r) * 128 + F.wave * 16 + quad * 4) = o; }
    }
    __syncthreads();
}
DI void gla_scan(const Frame& F, bf16* UT, const float* GD) {
    const int total = 16 * 8192;
    for (int e = F.bid * NT + F.tid; e < total; e += F.G * NT) {
        const int bh = e >> 13, q = e & 8191, dv = q >> 5, d4 = (q & 31) * 4;
        bf16* p = UT + ((size_t)(bh * 128) * 256 + dv) * 128 + d4; const float* gp = GD + (size_t)(bh * 128) * 128 + d4;
        f32x4 s = (f32x4){0.f, 0.f, 0.f, 0.f};
        for (int c0 = 0; c0 < 128; c0 += 8) {
            u32x2 u[8]; f32x4 g[8];
#pragma unroll
            for (int i = 0; i < 8; ++i) { u[i] = *(const u32x2*)(p + (size_t)(c0 + i) * 32768); g[i] = *(const f32x4*)(gp + (size_t)(c0 + i) * 128); }
#pragma unroll
            for (int i = 0; i < 8; ++i) { u32x2 o; o.x = pk2(s.x, s.y); o.y = pk2(s.z, s.w); *(u32x2*)(p + (size_t)(c0 + i) * 32768) = o;
                s.x = g[i].x * s.x + bflo(u[i].x); s.y = g[i].y * s.y + bfhi(u[i].x); s.z = g[i].z * s.z + bflo(u[i].y); s.w = g[i].w * s.w + bfhi(u[i].y); }
        }
    }
}
DI void gla_c2_task(int item, int ip, int lane, const bf16* QT, const bf16* KT, const bf16* VTG, const bf16* ST, const bf16* PROJ, const float* g_out, bf16* MIX) {
    const int c = item & 127, h = (item >> 7) & 3, b = item >> 9;
    const int r = lane & 15, quad = lane >> 4;
    const bf16* qb = QT + (size_t)item * 64 * 128; const bf16* kb = KT + (size_t)item * 64 * 128;
    const bf16* vb = VTG + (size_t)item * 256 * 64; const bf16* sb = ST + (size_t)item * 256 * 128;
    const int it1 = 2 * ip + 1;
    bf16x8 Qf[2][4];
#pragma unroll
    for (int e = 0; e < 2; ++e)
#pragma unroll
        for (int ks = 0; ks < 4; ++ks) Qf[e][ks] = *(const bf16x8*)(qb + ((2 * ip + e) * 16 + r) * 128 + ks * 32 + quad * 8);
    f32x4 S[2][4];
    {
        bf16x8 ka[16];
#pragma unroll
        for (int jt = 0; jt < 4; ++jt)
#pragma unroll
            for (int ks = 0; ks < 4; ++ks) ka[jt * 4 + ks] = *(const bf16x8*)(kb + (jt * 16 + r) * 128 + ks * 32 + quad * 8);
        __builtin_amdgcn_sched_barrier(0);
#pragma unroll
        for (int jt = 0; jt < 4; ++jt) { S[0][jt] = (f32x4){0.f, 0.f, 0.f, 0.f}; S[1][jt] = S[0][jt];
#pragma unroll
            for (int ks = 0; ks < 4; ++ks) { S[0][jt] = MFMA16(ka[jt * 4 + ks], Qf[0][ks], S[0][jt]); S[1][jt] = MFMA16(ka[jt * 4 + ks], Qf[1][ks], S[1][jt]); } }
        __builtin_amdgcn_sched_barrier(0);
    }
    bf16x8 pb[2][2];
#pragma unroll
    for (int e = 0; e < 2; ++e) { const int it = 2 * ip + e;
#pragma unroll
        for (int kk = 0; kk < 2; ++kk) { unsigned w[4];
#pragma unroll
            for (int t2 = 0; t2 < 2; ++t2) { const int jt = 2 * kk + t2; float v[4];
#pragma unroll
                for (int jj = 0; jj < 4; ++jj) v[jj] = (jt < it || (jt == it && quad * 4 + jj <= r)) ? S[e][jt][jj] : 0.f;
                w[2 * t2] = pk2(v[0], v[1]); w[2 * t2 + 1] = pk2(v[2], v[3]); }
            pb[e][kk] = __builtin_bit_cast(bf16x8, (u32x4){w[0], w[1], w[2], w[3]}); } }
    f32x4 o[2][16];
#pragma unroll
    for (int i = 0; i < 16; ++i) { o[0][i] = (f32x4){0.f, 0.f, 0.f, 0.f}; o[1][i] = o[0][i]; }
#pragma unroll
    for (int g = 0; g < 8; ++g) {
        bf16x8 sa[8];
#pragma unroll
        for (int q = 0; q < 2; ++q)
#pragma unroll
            for (int ks = 0; ks < 4; ++ks) sa[q * 4 + ks] = *(const bf16x8*)(sb + ((g * 2 + q) * 16 + r) * 128 + ks * 32 + quad * 8);
        __builtin_amdgcn_sched_barrier(0);
#pragma unroll
        for (int q = 0; q < 2; ++q)
#pragma unroll
            for (int ks = 0; ks < 4; ++ks) { o[0][g * 2 + q] = MFMA16(sa[q * 4 + ks], Qf[0][ks], o[0][g * 2 + q]); o[1][g * 2 + q] = MFMA16(sa[q * 4 + ks], Qf[1][ks], o[1][g * 2 + q]); }
        __builtin_amdgcn_sched_barrier(0);
    }
#pragma unroll
    for (int kk = 0; kk < 2; ++kk) {
        if (2 * kk <= it1) {
#pragma unroll
            for (int hh = 0; hh < 2; ++hh) {
                s16x4 vlo[8], vhi[8];
#pragma unroll
                for (int q = 0; q < 8; ++q) { const bf16* vp = vb + ((hh * 8 + q) * 16 + r) * 64 + kk * 32 + quad * 4; vlo[q] = *(const s16x4*)vp; vhi[q] = *(const s16x4*)(vp + 16); }
                __builtin_amdgcn_sched_barrier(0);
#pragma unroll
                for (int q = 0; q < 8; ++q) { const bf16x8 a = __builtin_shufflevector(vlo[q], vhi[q], 0, 1, 2, 3, 4, 5, 6, 7);
                    o[0][hh * 8 + q] = MFMA16(a, pb[0][kk], o[0][hh * 8 + q]); o[1][hh * 8 + q] = MFMA16(a, pb[1][kk], o[1][hh * 8 + q]); }
                __builtin_amdgcn_sched_barrier(0);
            }
        } }
#pragma unroll
    for (int e = 0; e < 2; ++e) {
        float ss = 0.f;
#pragma unroll
        for (int i = 0; i < 16; ++i) ss += (o[e][i][0] * o[e][i][0] + o[e][i][1] * o[e][i][1]) + (o[e][i][2] * o[e][i][2] + o[e][i][3] * o[e][i][3]);
        ss += __shfl_xor(ss, 16); ss += __shfl_xor(ss, 32);
        const float rstd = __builtin_amdgcn_rsqf(ss * (1.f / 256.f) + EPS);
        const size_t row = (size_t)b * T + (size_t)c * 64 + (2 * ip + e) * 16 + r;
#pragma unroll
        for (int hh = 0; hh < 2; ++hh) {
            u32x2 rv[8]; f32x4 gv[8];
#pragma unroll
            for (int q = 0; q < 8; ++q) { rv[q] = *(const u32x2*)(PROJ + row * LDP + C_RL + h * 256 + (hh * 8 + q) * 16 + quad * 4); gv[q] = *(const f32x4*)(g_out + (hh * 8 + q) * 16 + quad * 4); }
            __builtin_amdgcn_sched_barrier(0);
#pragma unroll
            for (int q = 0; q < 8; ++q) { const int i = hh * 8 + q, dv0 = i * 16 + quad * 4; const u32x2 rr = rv[q]; const f32x4 gg = gv[q];
                u32x2 w; w.x = pk2(o[e][i][0] * rstd * gg.x * silu_f(bflo(rr.x)), o[e][i][1] * rstd * gg.y * silu_f(bfhi(rr.x)));
                w.y = pk2(o[e][i][2] * rstd * gg.z * silu_f(bflo(rr.y)), o[e][i][3] * rstd * gg.w * silu_f(bfhi(rr.y)));
                *(u32x2*)(MIX + row * 2048 + 1024 + h * 256 + dv0) = w; }
            __builtin_amdgcn_sched_barrier(0);
        }
    }
}
constexpr float NEGF = -1e30f, MINIT = -1e4f;
constexpr int TILE_LDS = 32768;
DI int vswz(int dv) { return (dv & 7) ^ ((dv >> 3) & 1); }
DI void issue_k(const Frame& F, const bf16* src, unsigned ld, LAS unsigned char* buf) {
#pragma unroll
    for (int i = 0; i < 2; ++i) { const unsigned P = (unsigned)F.tid * 16u + i * 8192u, row = P >> 8, ch = ((P >> 4) & 15u) ^ (row & 15u);
        __builtin_amdgcn_global_load_lds((const unsigned*)(src + row * ld + ch * 8u), (LAS unsigned*)(buf + F.wave * 1024 + i * 8192), 16, 0, 0); }
}
DI void issue_v(const Frame& F, const bf16* src, unsigned ld, LAS unsigned char* buf) {
#pragma unroll
    for (int i = 0; i < 2; ++i) { const unsigned P = (unsigned)F.tid * 16u + i * 8192u, dv = P >> 7, ch = ((P >> 4) & 7u) ^ (unsigned)vswz((int)dv);
        __builtin_amdgcn_global_load_lds((const unsigned*)(src + dv * ld + ch * 8u), (LAS unsigned*)(buf + 16384 + F.wave * 1024 + i * 8192), 16, 0, 0); }
}
#define TILE_SYNC() do { asm volatile("s_waitcnt vmcnt(0)" ::: "memory"); __syncthreads(); } while (0)
DI bool tile_sync_far(float sl0, float sl1, float m0, float m1, float dn) { asm volatile("s_waitcnt vmcnt(0)" ::: "memory"); return __syncthreads_and((-sl0 * dn + 182.f < m0) && (-sl1 * dn + 182.f < m1)) != 0; }
#define TILE_SYNC_FAR(dn) tile_sync_far(sl0, sl1, m[0], m[1], (dn))
template <int MODE, bool EARLYV = false>
DI void flash_tile(const bool MASKED, const LAS unsigned char* buf, const bf16x8 (&Qf)[2][4], f32x4 (&O)[8][2], float (&m)[2], float (&l)[2],
                   float base0, float base1, float ks0, float ks1, int klo, int khi, int lane, LAS float* imp, int jb0, int tok0) {
    const int r = lane & 15, quad = lane >> 4;
    const int kx = (quad ^ r) & 3, kr2 = r >> 2;
    const int vs = vswz(r);
#pragma unroll 1
    for (int sub = 0; sub < 2; ++sub) {
        const LAS unsigned char* Kp = buf + (sub * 32 + r) * 256 + kx * 16;
        const float kq = (float)(sub * 32 + quad * 4);
        const float bq0 = base0 + ks0 * kq, bq1 = base1 + ks1 * kq;
        f32x4 S[2][2];
#pragma unroll
        for (int kt = 0; kt < 2; ++kt)
#pragma unroll
            for (int j = 0; j < 4; ++j) { S[kt][0][j] = ks0 * (float)(kt * 16 + j) + bq0; S[kt][1][j] = ks1 * (float)(kt * 16 + j) + bq1; }
        if (EARLYV) {
            bf16x8 ka[8];
#pragma unroll
            for (int kt = 0; kt < 2; ++kt)
#pragma unroll
                for (int ks = 0; ks < 4; ++ks) ka[kt * 4 + ks] = *(const LAS bf16x8*)(Kp + kt * 16 * 256 + ((ks ^ kr2) & 3) * 64);
            __builtin_amdgcn_sched_barrier(0);
#pragma unroll
            for (int kt = 0; kt < 2; ++kt)
#pragma unroll
                for (int ks = 0; ks < 4; ++ks) { S[kt][0] = MFMA16(ka[kt * 4 + ks], Qf[0][ks], S[kt][0]); S[kt][1] = MFMA16(ka[kt * 4 + ks], Qf[1][ks], S[kt][1]); }
            __builtin_amdgcn_sched_barrier(0);
        } else {
#pragma unroll
            for (int kt = 0; kt < 2; ++kt) {
                bf16x8 ka[4];
#pragma unroll
                for (int ks = 0; ks < 4; ++ks) ka[ks] = *(const LAS bf16x8*)(Kp + kt * 16 * 256 + ((ks ^ kr2) & 3) * 64);
                __builtin_amdgcn_sched_barrier(0);
#pragma unroll
                for (int ks = 0; ks < 4; ++ks) { S[kt][0] = MFMA16(ka[ks], Qf[0][ks], S[kt][0]); S[kt][1] = MFMA16(ka[ks], Qf[1][ks], S[kt][1]); }
                __builtin_amdgcn_sched_barrier(0);
            }
        }
        s16x4 vlo[8], vhi[8];
        if (MODE != 1 && EARLYV) {
            const LAS unsigned char* Vp = buf + 16384 + r * 128 + (quad & 1) * 8;
            const int c0 = ((sub * 4 + (quad >> 1)) ^ vs) * 16, c1 = ((sub * 4 + (quad >> 1) + 2) ^ vs) * 16;
#pragma unroll
            for (int dvt = 0; dvt < 8; ++dvt) { const LAS unsigned char* vp = Vp + dvt * 16 * 128; vlo[dvt] = *(const LAS s16x4*)(vp + c0); vhi[dvt] = *(const LAS s16x4*)(vp + c1); }
            __builtin_amdgcn_sched_barrier(0);
        }
        if (MASKED) {
            const unsigned span = (unsigned)(khi - klo);
#pragma unroll
            for (int kt = 0; kt < 2; ++kt)
#pragma unroll
                for (int j = 0; j < 4; ++j) { const bool ok = (khi >= klo) && (unsigned)(sub * 32 + kt * 16 + quad * 4 + j - klo) <= span;
                    S[kt][0][j] = ok ? S[kt][0][j] : NEGF; S[kt][1][j] = ok ? S[kt][1][j] : NEGF; }
        }
        if (MODE != 2) {
            const float mx0 = fmaxf(fmaxf(fmaxf(S[0][0][0], S[0][0][1]), fmaxf(S[0][0][2], S[0][0][3])), fmaxf(fmaxf(S[1][0][0], S[1][0][1]), fmaxf(S[1][0][2], S[1][0][3])));
            const float mx1 = fmaxf(fmaxf(fmaxf(S[0][1][0], S[0][1][1]), fmaxf(S[0][1][2], S[0][1][3])), fmaxf(fmaxf(S[1][1][0], S[1][1][1]), fmaxf(S[1][1][2], S[1][1][3])));
            if (__builtin_amdgcn_ballot_w64(mx0 > m[0] + 8.f || mx1 > m[1] + 8.f) != 0ull) {
                float q0 = fmaxf(mx0, __shfl_xor(mx0, 16)); q0 = fmaxf(q0, __shfl_xor(q0, 32));
                float q1 = fmaxf(mx1, __shfl_xor(mx1, 16)); q1 = fmaxf(q1, __shfl_xor(q1, 32));
                const float n0 = fmaxf(m[0], q0), n1 = fmaxf(m[1], q1);
                const float a0 = __builtin_amdgcn_exp2f(m[0] - n0), a1 = __builtin_amdgcn_exp2f(m[1] - n1);
                m[0] = n0; m[1] = n1; l[0] *= a0; l[1] *= a1;
                if (MODE == 0) {
#pragma unroll
                    for (int dvt = 0; dvt < 8; ++dvt) { O[dvt][0] *= a0; O[dvt][1] *= a1; } }
            }
        }
        float mn[2] = {m[0], m[1]};
#pragma unroll
        for (int rt = 0; rt < 2; ++rt) {
            const float scale = (MODE == 2) ? l[rt] : 1.f;
            float ps = 0.f;
#pragma unroll
            for (int kt = 0; kt < 2; ++kt)
#pragma unroll
                for (int j = 0; j < 4; ++j) { float p = __builtin_amdgcn_exp2f(S[kt][rt][j] - mn[rt]); if (MODE == 2) p *= scale; S[kt][rt][j] = p; ps += p; }
            if (MODE != 2) l[rt] += ps;
        }
        if (MODE == 2) {
#pragma unroll
            for (int kt = 0; kt < 2; ++kt) { f32x4 p4 = S[kt][0] + S[kt][1];
                p4[0] += __shfl_xor(p4[0], 8); p4[1] += __shfl_xor(p4[1], 8); p4[2] += __shfl_xor(p4[2], 8); p4[3] += __shfl_xor(p4[3], 8);
                if (r < 8) { const int jb = jb0 + sub * 8 + kt * 4 + quad; float* ip = (float*)(imp + (tok0 + r) * 129 + jb);
                    atomicAdd(ip, 2.f * (p4[0] + p4[1] + p4[2]) + p4[3]); if (jb + 1 < 128) atomicAdd(ip + 1, p4[3]); } }
        }
        if (MODE != 1) {
            bf16x8 pb[2];
#pragma unroll
            for (int rt = 0; rt < 2; ++rt) { u32x4 w; w.x = pk2(S[0][rt][0], S[0][rt][1]); w.y = pk2(S[0][rt][2], S[0][rt][3]);
                w.z = pk2(S[1][rt][0], S[1][rt][1]); w.w = pk2(S[1][rt][2], S[1][rt][3]); pb[rt] = __builtin_bit_cast(bf16x8, w); }
            __builtin_amdgcn_sched_barrier(0);
            if (!EARLYV) {
                const LAS unsigned char* Vp = buf + 16384 + r * 128 + (quad & 1) * 8;
                const int c0 = ((sub * 4 + (quad >> 1)) ^ vs) * 16, c1 = ((sub * 4 + (quad >> 1) + 2) ^ vs) * 16;
#pragma unroll
                for (int hv = 0; hv < 2; ++hv) {
                    s16x4 wlo[4], whi[4];
#pragma unroll
                    for (int q = 0; q < 4; ++q) { const LAS unsigned char* vp = Vp + (hv * 4 + q) * 16 * 128; wlo[q] = *(const LAS s16x4*)(vp + c0); whi[q] = *(const LAS s16x4*)(vp + c1); }
                    __builtin_amdgcn_sched_barrier(0);
#pragma unroll
                    for (int q = 0; q < 4; ++q) { const bf16x8 a = __builtin_shufflevector(wlo[q], whi[q], 0, 1, 2, 3, 4, 5, 6, 7);
                        O[hv * 4 + q][0] = MFMA16(a, pb[0], O[hv * 4 + q][0]); O[hv * 4 + q][1] = MFMA16(a, pb[1], O[hv * 4 + q][1]); }
                    __builtin_amdgcn_sched_barrier(0);
                }
            } else {
#pragma unroll
                for (int dvt = 0; dvt < 8; ++dvt) { const bf16x8 a = __builtin_shufflevector(vlo[dvt], vhi[dvt], 0, 1, 2, 3, 4, 5, 6, 7);
                    O[dvt][0] = MFMA16(a, pb[0], O[dvt][0]); O[dvt][1] = MFMA16(a, pb[1], O[dvt][1]); }
                __builtin_amdgcn_sched_barrier(0);
            }
        }
    }
}
DI void load_q_frags(const bf16* qp, const float* g, float scale, int quad, bf16x8 (&Qf)[4]) {
    u32x4 x[4]; float ss = 0.f;
#pragma unroll
    for (int ks = 0; ks < 4; ++ks) { x[ks] = *(const u32x4*)(qp + ks * 32 + quad * 8);
        const float a0 = bflo(x[ks].x), a1 = bfhi(x[ks].x), a2 = bflo(x[ks].y), a3 = bfhi(x[ks].y), a4 = bflo(x[ks].z), a5 = bfhi(x[ks].z), a6 = bflo(x[ks].w), a7 = bfhi(x[ks].w);
        ss += (a0 * a0 + a1 * a1) + (a2 * a2 + a3 * a3) + (a4 * a4 + a5 * a5) + (a6 * a6 + a7 * a7); }
    ss += __shfl_xor(ss, 16); ss += __shfl_xor(ss, 32);
    const float rs = __builtin_amdgcn_rsqf(ss * (1.f / 128.f) + EPS) * scale;
#pragma unroll
    for (int ks = 0; ks < 4; ++ks) { const f32x4 g0 = *(const f32x4*)(g + ks * 32 + quad * 8), g1 = *(const f32x4*)(g + ks * 32 + quad * 8 + 4);
        u32x4 w; w.x = pk2(bflo(x[ks].x) * rs * g0.x, bfhi(x[ks].x) * rs * g0.y); w.y = pk2(bflo(x[ks].y) * rs * g0.z, bfhi(x[ks].y) * rs * g0.w);
        w.z = pk2(bflo(x[ks].z) * rs * g1.x, bfhi(x[ks].z) * rs * g1.y); w.w = pk2(bflo(x[ks].w) * rs * g1.z, bfhi(x[ks].w) * rs * g1.w);
        Qf[ks] = __builtin_bit_cast(bf16x8, w); }
}
constexpr int NS_IMP = 65536, NS_SEL = 98560, NS_BF = 99584, NS_LIST = 100096, NS_NL = 100608;
constexpr float LOG2E = 1.4426950408889634f;
DI float quad_sum(float v) { v += __shfl_xor(v, 16); v += __shfl_xor(v, 32); return v; }

DI void nsa_item(const Frame& F0, int item, const bf16* PROJ, const bf16* KC, const bf16* VCT, const bf16* VST, const bf16* VWT,
                 const float* g_q, const float* b_gate, const float* g_out, bf16* MIX, float* NSAO) {
    Frame F = F0;
    { int t_ = F0.tid; asm volatile("" : "+v"(t_)); __builtin_assume(t_ >= 0 && t_ < NT); F.tid = t_; F.lane = t_ & 63; }
    const int c = 127 - (item >> 3), kvh = 1 - (item & 1), b = (item >> 1) & 3;
    const int lane = F.lane, r = lane & 15, quad = lane >> 4;
    LAS float* IMP = (LAS float*)(F.lds + NS_IMP); LAS unsigned* SEL = (LAS unsigned*)(F.lds + NS_SEL); LAS unsigned* BFL = (LAS unsigned*)(F.lds + NS_BF);
    LAS int* LIST = (LAS int*)(F.lds + NS_LIST); LAS int* NLp = (LAS int*)(F.lds + NS_NL);
    const int tok = 8 * F.wave + (r & 7), t = 64 * c + tok;
    const unsigned trow = (unsigned)(b * T + t);
    const int hd0 = kvh * 4 + (r >> 3), hd1 = hd0 + 2;
    const float sl0 = exp2f(-(float)(hd0 + 1)) * LOG2E, sl1 = exp2f(-(float)(hd1 + 1)) * LOG2E;
    bf16x8 Qf[2][4];
    load_q_frags(PROJ + (size_t)trow * LDP + C_Q + hd0 * 128, g_q, 0.08838834764831845f * LOG2E, quad, Qf[0]);
    __builtin_amdgcn_sched_barrier(0);
    load_q_frags(PROJ + (size_t)trow * LDP + C_Q + hd1 * 128, g_q, 0.08838834764831845f * LOG2E, quad, Qf[1]);
    __builtin_amdgcn_sched_barrier(0);
    unsigned gpk0, gpk1, gpk2;
    { float gl[6], gb[6];
#pragma unroll
      for (int br = 0; br < 3; ++br) { gl[br] = bf2f(PROJ[(size_t)trow * LDP + C_GATE + hd0 * 3 + br]); gl[3 + br] = bf2f(PROJ[(size_t)trow * LDP + C_GATE + hd1 * 3 + br]); gb[br] = b_gate[hd0 * 3 + br]; gb[3 + br] = b_gate[hd1 * 3 + br]; }
      __builtin_amdgcn_sched_barrier(0);
      float gg[6];
#pragma unroll
      for (int i = 0; i < 6; ++i) gg[i] = __builtin_amdgcn_rcpf(1.f + __expf(-(gl[i] + gb[i])));
      gpk0 = pk2(gg[0], gg[3]); gpk1 = pk2(gg[1], gg[4]); gpk2 = pk2(gg[2], gg[5]); }
#define NSA_GATE(rt, br) ((rt) ? bfhi((br) == 0 ? gpk0 : (br) == 1 ? gpk1 : gpk2) : bflo((br) == 0 ? gpk0 : (br) == 1 ? gpk1 : gpk2))
    f32x4 O[8][2]; float m[2], l[2];
    f32x4* oscb = (f32x4*)NSAO + ((size_t)(F.bid * NWAVES + F.wave) * 16) * 64;
#define osc(k) oscb[(unsigned)((k) * 64 + lane)]
#pragma unroll
    for (int i = 0; i < 8; ++i) { O[i][0] = (f32x4){0.f, 0.f, 0.f, 0.f}; O[i][1] = O[i][0]; }
    for (int i = F.tid; i < 64 * 129; i += NT) IMP[i] = 0.f;
    if (F.tid < 256) SEL[F.tid] = 0u;
    LAS unsigned char* const lds = F.lds;
    const bf16* kc = KC + (size_t)(b * 2 + kvh) * 512 * 128; const bf16* vct = VCT + (size_t)(b * 2 + kvh) * 128 * 512;
    const int nct = (4 * c + 3 + 63) >> 6;
    m[0] = MINIT; m[1] = MINIT; l[0] = 0.f; l[1] = 0.f;
    __syncthreads();
    issue_k(F, kc + (size_t)(nct - 1) * 64 * 128, 128, lds); TILE_SYNC();
    for (int kt = nct - 1, n = 0; kt >= 0; --kt, ++n) {
        LAS unsigned char* cur = lds + (n & 1) * TILE_LDS; LAS unsigned char* nxt = lds + ((n & 1) ^ 1) * TILE_LDS;
        if (kt > 0) issue_k(F, kc + (size_t)(kt - 1) * 64 * 128, 128, nxt);
        const float d0 = (float)(t - 16 * (kt * 64)) - 15.5f; const int khi = (t - 31 - 16 * (kt * 64)) >> 4;
        flash_tile<1, true>(kt * 64 + 63 > 4 * c - 2, cur, Qf, O, m, l, -sl0 * d0, -sl1 * d0, 16.f * sl0, 16.f * sl1, 0, khi < 63 ? khi : 63, lane, IMP, 0, 0);
        TILE_SYNC();
    }
#pragma unroll
    for (int rt = 0; rt < 2; ++rt) { const float lt = quad_sum(l[rt]); l[rt] = lt > 0.f ? 1.f / lt : 0.f; }
    issue_k(F, kc + (size_t)(nct - 1) * 64 * 128, 128, lds); issue_v(F, vct + (nct - 1) * 64, 512, lds); TILE_SYNC();
    for (int kt = nct - 1, n = 0; kt >= 0; --kt, ++n) {
        LAS unsigned char* cur = lds + (n & 1) * TILE_LDS; LAS unsigned char* nxt = lds + ((n & 1) ^ 1) * TILE_LDS;
        if (kt > 0) { issue_k(F, kc + (size_t)(kt - 1) * 64 * 128, 128, nxt); issue_v(F, vct + (kt - 1) * 64, 512, nxt); }
        const float d0 = (float)(t - 16 * (kt * 64)) - 15.5f; const int khi = (t - 31 - 16 * (kt * 64)) >> 4;
        flash_tile<2, true>(kt * 64 + 63 > 4 * c - 2, cur, Qf, O, m, l, -sl0 * d0, -sl1 * d0, 16.f * sl0, 16.f * sl1, 0, khi < 63 ? khi : 63, lane, IMP, kt * 16, 8 * F.wave);
        TILE_SYNC();
    }
    { const float g00 = NSA_GATE(0, 0), g10 = NSA_GATE(1, 0);
#pragma unroll
      for (int i = 0; i < 8; ++i) { osc(i * 2) = O[i][0] * g00; osc(i * 2 + 1) = O[i][1] * g10; O[i][0] = (f32x4){0.f, 0.f, 0.f, 0.f}; O[i][1] = O[i][0]; } }
#pragma unroll 1
    for (int rnd = 0; rnd < 2; ++rnd) {
        const int ts = rnd * 32 + (F.tid >> 4), part = F.tid & 15; unsigned bits = 0u;
        if (c >= 16) {
            unsigned key[8];
#pragma unroll
            for (int q = 0; q < 8; ++q) { const int jq = part * 8 + q; key[q] = (jq >= 1 && jq <= c - 2) ? __float_as_uint(IMP[ts * 129 + jq]) + 1u : 0u; }
            unsigned Tk = 0u;
#pragma unroll 1
            for (int bit = 30; bit >= 0; --bit) { const unsigned trial = Tk | (1u << bit); int cnt = 0;
#pragma unroll
                for (int q = 0; q < 8; ++q) cnt += key[q] >= trial ? 1 : 0;
                cnt += __shfl_xor(cnt, 1); cnt += __shfl_xor(cnt, 2); cnt += __shfl_xor(cnt, 4); cnt += __shfl_xor(cnt, 8);
                if (cnt >= 13) Tk = trial; }
            int gt = 0, eq = 0;
#pragma unroll
            for (int q = 0; q < 8; ++q) { gt += key[q] > Tk ? 1 : 0; eq += key[q] == Tk ? 1 : 0; }
            int gtt = gt; gtt += __shfl_xor(gtt, 1); gtt += __shfl_xor(gtt, 2); gtt += __shfl_xor(gtt, 4); gtt += __shfl_xor(gtt, 8);
            int pre = eq;
            { int v = __shfl_up(pre, 1, 16); if (part >= 1) pre += v; v = __shfl_up(pre, 2, 16); if (part >= 2) pre += v; v = __shfl_up(pre, 4, 16); if (part >= 4) pre += v; v = __shfl_up(pre, 8, 16); if (part >= 8) pre += v; }
            int run = pre - eq; const int need = 13 - gtt;
#pragma unroll
            for (int q = 0; q < 8; ++q) { const int jq = part * 8 + q; bool pick = key[q] > Tk;
                if (key[q] == Tk && Tk != 0u) { pick = run < need; ++run; }
                pick = pick || jq == 0 || jq == c || jq == c - 1; bits |= pick ? (1u << q) : 0u; }
        } else {
#pragma unroll
            for (int q = 0; q < 8; ++q) bits |= (part * 8 + q <= c) ? (1u << q) : 0u;
        }
        if (bits) atomicOr((unsigned*)(SEL + ts * 4 + (part >> 2)), bits << ((part & 3) * 8));
    }
    __syncthreads();
    if (F.tid < 128) { unsigned any = 0u; for (int k = 0; k < 64; ++k) any |= SEL[k * 4 + (F.tid >> 5)]; BFL[F.tid] = (any >> (F.tid & 31)) & 1u; }
    unsigned wm0, wm1, wm2, wm3;
    { unsigned x0 = SEL[tok * 4], x1 = SEL[tok * 4 + 1], x2 = SEL[tok * 4 + 2], x3 = SEL[tok * 4 + 3];
#pragma unroll
      for (int o = 1; o < 8; o <<= 1) { x0 |= __shfl_xor(x0, o); x1 |= __shfl_xor(x1, o); x2 |= __shfl_xor(x2, o); x3 |= __shfl_xor(x3, o); }
      wm0 = __builtin_amdgcn_readfirstlane(x0); wm1 = __builtin_amdgcn_readfirstlane(x1); wm2 = __builtin_amdgcn_readfirstlane(x2); wm3 = __builtin_amdgcn_readfirstlane(x3); }
    __syncthreads();
    if (F.wave == 0) { const bool f0 = lane <= c && BFL[lane] != 0u, f1 = lane + 64 <= c && BFL[lane + 64] != 0u;
        const unsigned long long m0 = __builtin_amdgcn_ballot_w64(f0), m1 = __builtin_amdgcn_ballot_w64(f1), lt = (1ull << lane) - 1ull;
        if (f0) LIST[__builtin_popcountll(m0 & lt)] = lane;
        if (f1) LIST[__builtin_popcountll(m0) + __builtin_popcountll(m1 & lt)] = lane + 64;
        if (lane == 0) NLp[0] = __builtin_popcountll(m0) + __builtin_popcountll(m1); }
    __syncthreads();
    m[0] = MINIT; m[1] = MINIT; l[0] = 0.f; l[1] = 0.f;
    const bf16* ksb = PROJ + (size_t)b * T * LDP + C_KS + kvh * 128; const bf16* vsb = VST + (size_t)(b * 2 + kvh) * 128 * 8192;
    const int nl = NLp[0];
    { const int jb = LIST[nl - 1]; issue_k(F, ksb + (size_t)jb * 64 * LDP, LDP, lds); issue_v(F, vsb + (size_t)jb * 8192, 64, lds); }
    TILE_SYNC();
    for (int idx = nl - 1, n = 0; idx >= 0; --idx, ++n) {
        LAS unsigned char* cur = lds + (n & 1) * TILE_LDS; LAS unsigned char* nxt = lds + ((n & 1) ^ 1) * TILE_LDS;
        const int jb = LIST[idx];
        if (idx > 0) { const int jn = LIST[idx - 1]; issue_k(F, ksb + (size_t)jn * 64 * LDP, LDP, nxt); issue_v(F, vsb + (size_t)jn * 8192, 64, nxt); }
        const unsigned ww = jb < 32 ? wm0 : jb < 64 ? wm1 : jb < 96 ? wm2 : wm3;
        if ((ww >> (jb & 31)) & 1u) {
            const bool sel = ((SEL[tok * 4 + (jb >> 5)] >> (jb & 31)) & 1u) != 0u;
            const float d0 = (float)(t - jb * 64);
            const float b0 = sel ? -sl0 * d0 : NEGF, b1 = sel ? -sl1 * d0 : NEGF;
            flash_tile<0, true>(jb == c, cur, Qf, O, m, l, b0, b1, sl0, sl1, 0, tok, lane, IMP, 0, 0);
        }
        TILE_SYNC();
    }
#pragma unroll
    for (int rt = 0; rt < 2; ++rt) { const float lt = quad_sum(l[rt]); const float f = (lt > 0.f ? 1.f / lt : 0.f) * NSA_GATE(rt, 1);
        f32x4 tv[8];
#pragma unroll
        for (int i = 0; i < 8; ++i) tv[i] = osc(i * 2 + rt);
        __builtin_amdgcn_sched_barrier(0);
#pragma unroll
        for (int i = 0; i < 8; ++i) { osc(i * 2 + rt) = tv[i] + O[i][rt] * f; O[i][rt] = (f32x4){0.f, 0.f, 0.f, 0.f}; } }
    m[0] = MINIT; m[1] = MINIT; l[0] = 0.f; l[1] = 0.f;
    const bf16* kwb = PROJ + (size_t)b * T * LDP + C_KW + kvh * 128; const bf16* vwb = VWT + (size_t)(b * 2 + kvh) * 128 * 8192;
    const int jlo = c >= 8 ? c - 8 : 0;
    issue_k(F, kwb + (size_t)c * 64 * LDP, LDP, lds); issue_v(F, vwb + (size_t)c * 8192, 64, lds);
    TILE_SYNC();
    for (int jb = c, n = 0; jb >= jlo; --jb, ++n) {
        LAS unsigned char* cur = lds + (n & 1) * TILE_LDS; LAS unsigned char* nxt = lds + ((n & 1) ^ 1) * TILE_LDS;
        if (jb > jlo) { issue_k(F, kwb + (size_t)(jb - 1) * 64 * LDP, LDP, nxt); issue_v(F, vwb + (size_t)(jb - 1) * 8192, 64, nxt); }
        const int dd = t - jb * 64; const float d0 = (float)dd;
        flash_tile<0, true>(jb == c || jb == c - 8, cur, Qf, O, m, l, -sl0 * d0, -sl1 * d0, sl0, sl1, dd - 511 > 0 ? dd - 511 : 0, dd < 63 ? dd : 63, lane, IMP, 0, 0);
        TILE_SYNC();
    }
#pragma unroll
    for (int rt = 0; rt < 2; ++rt) { const float lt = quad_sum(l[rt]); const float f = (lt > 0.f ? 1.f / lt : 0.f) * NSA_GATE(rt, 2);
        f32x4 tv[8];
#pragma unroll
        for (int i = 0; i < 8; ++i) tv[i] = osc(i * 2 + rt);
        __builtin_amdgcn_sched_barrier(0);
#pragma unroll
        for (int i = 0; i < 8; ++i) O[i][rt] = tv[i] + O[i][rt] * f; }
    f32x4 gnv[8];
#pragma unroll
    for (int i = 0; i < 8; ++i) gnv[i] = *(const f32x4*)(g_out + i * 16 + quad * 4);
    __builtin_amdgcn_sched_barrier(0);
#pragma unroll
    for (int rt = 0; rt < 2; ++rt) { float ss = 0.f;
#pragma unroll
        for (int i = 0; i < 8; ++i) ss += (O[i][rt][0] * O[i][rt][0] + O[i][rt][1] * O[i][rt][1]) + (O[i][rt][2] * O[i][rt][2] + O[i][rt][3] * O[i][rt][3]);
        const float rstd = __builtin_amdgcn_rsqf(quad_sum(ss) * (1.f / 128.f) + EPS);
        const int hd = rt ? hd1 : hd0;
#pragma unroll
        for (int i = 0; i < 8; ++i) { const int dv0 = i * 16 + quad * 4; const f32x4 gg = gnv[i];
            u32x2 w; w.x = pk2(O[i][rt][0] * rstd * gg.x, O[i][rt][1] * rstd * gg.y); w.y = pk2(O[i][rt][2] * rstd * gg.z, O[i][rt][3] * rstd * gg.w);
            *(u32x2*)(MIX + (size_t)trow * 2048 + hd * 128 + dv0) = w; } }
    __syncthreads();
}

DI void cross_item(const Frame& F, int item, const bf16* CQ, const bf16* CKV, const bf16* CVT, const float* g_cq, bf16* CO) {
    const int tile = item & 31, h = (item >> 5) & 3, b = item >> 7;
    const int lane = F.lane, r = lane & 15, quad = lane >> 4;
    LAS unsigned char* const lds = F.lds;
    const size_t row0 = (size_t)b * T + tile * 256 + F.wave * 32 + r;
    bf16x8 Qf[2][4];
    load_q_frags(CQ + row0 * 512 + h * 128, g_cq, 0.08838834764831845f * LOG2E, quad, Qf[0]);
    load_q_frags(CQ + (row0 + 16) * 512 + h * 128, g_cq, 0.08838834764831845f * LOG2E, quad, Qf[1]);
    f32x4 O[8][2]; float m[2] = {MINIT, MINIT}, l[2] = {0.f, 0.f};
#pragma unroll
    for (int i = 0; i < 8; ++i) { O[i][0] = (f32x4){0.f, 0.f, 0.f, 0.f}; O[i][1] = O[i][0]; }
    const bf16* kb = CKV + (size_t)b * 256 * 1024 + h * 128; const bf16* vb = CVT + (size_t)(b * 4 + h) * 128 * 256;
    issue_k(F, kb, 1024, lds); issue_v(F, vb, 256, lds); TILE_SYNC();
    for (int kt = 0; kt < 4; ++kt) {
        LAS unsigned char* cur = lds + (kt & 1) * TILE_LDS; LAS unsigned char* nxt = lds + ((kt & 1) ^ 1) * TILE_LDS;
        if (kt < 3) { issue_k(F, kb + (size_t)(kt + 1) * 64 * 1024, 1024, nxt); issue_v(F, vb + (kt + 1) * 64, 256, nxt); }
        flash_tile<0, true>(false, cur, Qf, O, m, l, 0.f, 0.f, 0.f, 0.f, 0, 63, lane, (LAS float*)nullptr, 0, 0);
        TILE_SYNC();
    }
#pragma unroll
    for (int rt = 0; rt < 2; ++rt) { const float lt = quad_sum(l[rt]); const float f = lt > 0.f ? 1.f / lt : 0.f;
#pragma unroll
        for (int i = 0; i < 8; ++i) { u32x2 w; w.x = pk2(O[i][rt][0] * f, O[i][rt][1] * f); w.y = pk2(O[i][rt][2] * f, O[i][rt][3] * f);
            *(u32x2*)(CO + (row0 + rt * 16) * 512 + h * 128 + i * 16 + quad * 4) = w; } }
    __syncthreads();
}
struct Args { const float* in[31]; float* out; unsigned char* ws; int ph_lo, ph_hi; };
enum { I_X = 0, I_MEM, I_GMIX, I_WIN, I_BGATE, I_GQ, I_GKC, I_GKS, I_GKW, I_PEK, I_PEV, I_WCK1, I_WCK2, I_WCV1, I_WCV2, I_GNSA, I_WGK2, I_BGK, I_GGLA, I_WOUT,
       I_GCROSS, I_GMEM, I_WCQ, I_WCK, I_WCV, I_GCQ, I_GCK, I_WCO, I_GFFN, I_WGU, I_WDOWN };
constexpr int NPHASE = 13;
#define XB_TMO      128
#define XB_XCNT(j)  (256  + 64 * (j))
#define XB_XSUB(j)  (1280 + 64 * (j))
#define XB_XGEN(j)  (2304 + 64 * (j))
#define XB_TOP      3328
#define XB_TOPGEN   3392
#define XCD_BAR_WORDS 3456
#define XB_SPIN_CAP (1u << 18)

__device__ __forceinline__ unsigned xb_ld(unsigned* p)              { return __hip_atomic_load(p, __ATOMIC_RELAXED, __HIP_MEMORY_SCOPE_AGENT); }
__device__ __forceinline__ unsigned xb_add(unsigned* p, unsigned v) { return __hip_atomic_fetch_add(p, v, __ATOMIC_RELAXED, __HIP_MEMORY_SCOPE_AGENT); }
__device__ __forceinline__ unsigned xb_xcc_id() { return (unsigned)__builtin_amdgcn_s_getreg((3 << 11) | 20) & 0xFu; }
#define XB_SPIN(cond, bar) do { unsigned _sp = 0; while (cond) { __builtin_amdgcn_s_sleep(1); \
    if ((++_sp & 255u) == 0u) { if (xb_ld(&(bar)[XB_TMO])) break; if (_sp > XB_SPIN_CAP) { atomicAdd(&(bar)[XB_TMO], 1u); break; } } } } while (0)

struct XcdBarrier {
    unsigned* bar; unsigned x;
    volatile LAS unsigned* st;
};

__device__ __forceinline__ XcdBarrier xcd_barrier_post(unsigned* bar, volatile LAS unsigned* st, int tid) {
    XcdBarrier b; b.bar = bar; b.x = xb_xcc_id(); b.st = st;
    if (tid == 0) (void)xb_add(&bar[XB_XCNT(b.x)], 1u);
    return b;
}
__device__ __forceinline__ void xcd_barrier_complete(unsigned* bar, unsigned x, unsigned& nloc, unsigned& nx) {
    const unsigned G = gridDim.x * gridDim.y * gridDim.z;
    unsigned sum, cnt, mine, sp = 0u;
    for (;;) {
        sum = 0u; cnt = 0u; mine = 0u;
#pragma unroll
        for (unsigned j = 0; j < 16; ++j) { const unsigned c = xb_ld(&bar[XB_XCNT(j)]); sum += c; cnt += (c > 0u) ? 1u : 0u; mine = (j == x) ? c : mine; }
        if (sum == G) break;
        __builtin_amdgcn_s_sleep(1);
        if ((++sp & 255u) == 0u) { if (xb_ld(&bar[XB_TMO])) break; if (sp > XB_SPIN_CAP) { atomicAdd(&bar[XB_TMO], 1u); break; } }
    }
    nloc = mine > 0u ? mine : 1u; nx = cnt > 0u ? cnt : 1u;
}

__device__ __forceinline__ void xcd_barrier(const XcdBarrier& b, int tid) {
    asm volatile("s_waitcnt vmcnt(0)" ::: "memory");
    __syncthreads();
    if (tid == 0) {
        unsigned* bar = b.bar;
        __builtin_amdgcn_s_waitcnt(0);
        unsigned nloc = b.st[0], nx = b.st[1];
        if (nloc == 0u) { xcd_barrier_complete(bar, b.x, nloc, nx); b.st[0] = nloc; b.st[1] = nx; }
        const unsigned old = xb_add(&bar[XB_XSUB(b.x)], 1u);
        const unsigned gen = old / nloc;
        if (old + 1u == (gen + 1u) * nloc) {
            __builtin_amdgcn_fence(__ATOMIC_RELEASE, "agent");
            asm volatile("s_waitcnt vmcnt(0)" ::: "memory");
            const unsigned og = xb_add(&bar[XB_TOP], 1u);
            const unsigned tg = og / nx;
            if (og + 1u == (tg + 1u) * nx) xb_add(&bar[XB_TOPGEN], 1u);
            else XB_SPIN(xb_ld(&bar[XB_TOPGEN]) == tg, bar);
            __builtin_amdgcn_fence(__ATOMIC_ACQUIRE, "agent");
            xb_add(&bar[XB_XGEN(b.x)], 1u);
            asm volatile("s_waitcnt vmcnt(0)" ::: "memory");
        } else {
            XB_SPIN(xb_ld(&bar[XB_XGEN(b.x)]) == gen, bar);
            __builtin_amdgcn_fence(__ATOMIC_ACQUIRE, "agent");
            asm volatile("s_waitcnt vmcnt(0)" ::: "memory");
        }
    }
    __syncthreads();
}

DI void grid_bar(unsigned* bar, unsigned target, int tid) {
    asm volatile("s_waitcnt vmcnt(0)" ::: "memory");
    __syncthreads();
    if (tid == 0) {
        __builtin_amdgcn_fence(__ATOMIC_RELEASE, "agent");
        asm volatile("s_waitcnt vmcnt(0)" ::: "memory");
        __hip_atomic_fetch_add(bar, 1u, __ATOMIC_RELAXED, __HIP_MEMORY_SCOPE_AGENT);
        while (__hip_atomic_load(bar, __ATOMIC_RELAXED, __HIP_MEMORY_SCOPE_AGENT) < target) __builtin_amdgcn_s_sleep(2);
        __builtin_amdgcn_fence(__ATOMIC_ACQUIRE, "agent");
        asm volatile("s_waitcnt vmcnt(0)" ::: "memory");
    }
    __syncthreads();
}
DI int next_item(unsigned* ctr, LAS int* slot, int tid) {
    __syncthreads();
    if (tid == 0) *slot = (int)__hip_atomic_fetch_add(ctr, 1u, __ATOMIC_RELAXED, __HIP_MEMORY_SCOPE_AGENT);
    __syncthreads();
    return *slot;
}
#define CTR(k) ((unsigned*)(AWS + WS_BAR) + 16 * (k))
#define SLOT ((LAS int*)(F.lds + LDS_BYTES - 64))
typedef const __attribute__((address_space(4))) Args* KArgsP;
DI KArgsP kargs() { auto p = __builtin_amdgcn_kernarg_segment_ptr(); asm volatile("" : "+s"(p)); return (KArgsP)p; }
#define AIN(k) ((const float*)kargs()->in[k])
#define AOUT ((float*)kargs()->out)
#define AWS ((unsigned char*)kargs()->ws)
__global__ void __launch_bounds__(NT, 2) mega(Args a) {
    extern __shared__ __attribute__((aligned(16))) unsigned char lds_raw[];
    cg::grid_group grid = cg::this_grid();
    Frame F; F.lds = (LAS unsigned char*)lds_raw; F.tid = threadIdx.x; F.lane = F.tid & 63; F.wave = __builtin_amdgcn_readfirstlane(F.tid >> 6);
    F.G = gridDim.x; F.bid = blockIdx.x; F.in = nullptr;
    ((LAS int*)(F.lds + LDS_BYTES - 4096))[F.tid] = F.tid;
    __syncthreads();
#define WT_IN ((bf16*)(AWS + WS_WT_IN))
#define WT_OUT ((bf16*)(AWS + WS_WT_OUT))
#define WT_CQ ((bf16*)(AWS + WS_WT_CQ))
#define WT_CKV ((bf16*)(AWS + WS_WT_CKV))
#define WT_CO ((bf16*)(AWS + WS_WT_CO))
#define WT_GU ((bf16*)(AWS + WS_WT_GU))
#define WT_DOWN ((bf16*)(AWS + WS_WT_DOWN))
#define WT_C1K ((bf16*)(AWS + WS_WT_C1K))
#define WT_C1V ((bf16*)(AWS + WS_WT_C1V))
#define WT_C2K ((bf16*)(AWS + WS_WT_C2K))
#define WT_C2V ((bf16*)(AWS + WS_WT_C2V))
#define HM ((bf16*)(AWS + WS_HM))
#define CKV ((bf16*)(AWS + WS_CKV))
#define CVT ((bf16*)(AWS + WS_CVT))
#define KC ((bf16*)(AWS + WS_KC))
#define VCT ((bf16*)(AWS + WS_VCT))
#define VST ((bf16*)(AWS + WS_VST))
#define VWT ((bf16*)(AWS + WS_VWT))
#define CQ ((bf16*)(AWS + WS_CQ))
#define CO ((bf16*)(AWS + WS_CO))
#define H ((bf16*)(AWS + WS_H))
#define MIX ((bf16*)(AWS + WS_MIX))
#define UT ((bf16*)(AWS + WS_UT))
#define PROJ ((bf16*)(AWS + WS_PROJ))
#define HID ((bf16*)(AWS + WS_HID))
#define GD ((float*)(AWS + WS_GD))
    const int lo = a.ph_lo, hi = a.ph_hi;
    if (hi > 1000) grid.sync();
    { volatile LAS unsigned* st_ = (volatile LAS unsigned*)(F.lds + LDS_BYTES - 128); if (F.tid < 2) st_[F.tid] = 0u; }
    __syncthreads();
    const unsigned xcc_id_ = xcd_barrier_post((unsigned*)(AWS + WS_BAR + 4096), (volatile LAS unsigned*)(F.lds + LDS_BYTES - 128), F.tid).x;
#ifndef PHM
#define PHM 0x1fff
#endif
#define IN(k) (((PHM >> (k)) & 1) && lo <= (k) && (k) < hi)
#ifndef RPT
#define RPT 0
#endif
#define NREP(k) (1 + ((RPT >> (k)) & 1))
#define SEAM(k) do { if ((k) + 1 < hi) { XcdBarrier xb_; xb_.bar = (unsigned*)(AWS + WS_BAR + 4096); xb_.x = xcc_id_; xb_.st = (volatile LAS unsigned*)(F.lds + LDS_BYTES - 128); xcd_barrier(xb_, F.tid); } } while (0)

#define REPEAT(k) for (int rep = 0; rep < NREP(k); ++rep)
#define REFRESH() do { int l_; asm volatile("v_mbcnt_lo_u32_b32 %0, -1, 0\n\tv_mbcnt_hi_u32_b32 %0, -1, %0" : "=v"(l_)); int t_ = ((LAS int*)(F.lds + LDS_BYTES - 4096))[F.wave * 64 + l_]; __builtin_assume(t_ >= 0 && t_ < NT); F.tid = t_; F.lane = t_ & 63; } while (0)
#define KILL() do { F.tid = 0; F.lane = 0; } while (0)
#define XB H
    KILL(); if (IN(0)) { REFRESH();
        REPEAT(0) {
        LAS float* scr = (LAS float*)(F.lds + F.wave * 16384);
        const int gw = F.bid * NWAVES + F.wave, NGW = F.G * NWAVES;
        constexpr int NITEMS = 32 * 184 + 2 * 32 * 16 + 2 * 64 * 8 + 2 * 4 * 4;
        for (int it = gw; it < NITEMS; it += NGW) { int r = it;
            if (transpose_mat(r, AIN(I_WIN), 2048, DIN, LDP, WT_IN, 0, 0, scr, F.lane)) continue;
            if (transpose_mat(r, AIN(I_WCK), 2048, 512, 512, WT_CKV, 0, 0, scr, F.lane)) continue;
            if (transpose_mat(r, AIN(I_WCV), 2048, 512, 512, WT_CKV, 512, 0, scr, F.lane)) continue;
            if (transpose_mat(r, AIN(I_WCK1), 4096, 256, 256, WT_C1K, 0, 0, scr, F.lane)) continue;
            if (transpose_mat(r, AIN(I_WCV1), 4096, 256, 256, WT_C1V, 0, 0, scr, F.lane)) continue;
            if (transpose_mat(r, AIN(I_WCK2), 256, 128, 128, WT_C2K, 0, 0, scr, F.lane)) continue;
            transpose_mat(r, AIN(I_WCV2), 256, 128, 128, WT_C2V, 0, 0, scr, F.lane);
        }
        rms_rows_phase(F, AIN(I_X), AIN(I_GMIX), H, M);
        rms_rows_phase(F, AIN(I_MEM), AIN(I_GMEM), HM, MM);
        { float* z = (float*)(AWS + WS_SS1); for (int i = F.bid * NT + F.tid; i < 2 * 65536; i += F.G * NT) z[i] = 0.f; }
        }
        SEAM(0);
    }
#ifdef XBAR
    for (int xb = 0; xb < XBAR; ++xb) { bar_target += (unsigned)F.G; grid_bar((unsigned*)(AWS + WS_BAR), bar_target, F.tid); }
#endif
    KILL(); if (IN(1)) { REFRESH();
        REPEAT(1) {
        { pg8::Gemm g{H, WT_IN, M, LDP, 2048}; pg8::StaticOrder S; S.init(M, LDP, F.G, F.bid); pg8::EpiBf16 E{PROJ, LDP, nullptr};
          pg8::gemm_phase<pg8::EpiBf16, pg8::StaticOrder, true, true>(F.lds, g, S, E, F.tid); }
        { pg8::Gemm g{HM, WT_CKV, MM, 1024, 2048}; pg8::StaticOrder S; S.init(MM, 1024, F.G, (F.bid + 16) % F.G); pg8::EpiBf16 E{CKV, 1024, nullptr};
          pg8::gemm_phase<pg8::EpiBf16, pg8::StaticOrder, true, true>(F.lds, g, S, E, F.tid); }
        }
        SEAM(1);
    }
    KILL(); if (IN(2)) { REFRESH();
        REPEAT(2) {
        for (int it = next_item(CTR(1 + 4 * rep), SLOT, F.tid); it < 256 + 512 + 16 + 2048; it = next_item(CTR(1 + 4 * rep), SLOT, F.tid)) {
            if (it < 256) compress_item(F, it, PROJ, AIN(I_PEK), AIN(I_PEV), WT_C1K, WT_C1V, WT_C2K, WT_C2V, AIN(I_GKC), KC, VCT);
            else if (it < 768) { if (rep) continue; const int i = it - 256, b = i >> 7, blk = i & 127;
                prep_item(F, PROJ, LDP, b * T + blk * 64, C_KS, C_VS, 512, AIN(I_GKS), AIN(I_GKW), VST + ((size_t)(b * 2) * 128 + blk) * 8192, (size_t)128 * 8192, (WS_VWT - WS_VST) / 2, 64, 0); }
            else if (it < 784) { if (rep) continue; const int i = it - 768, b = i >> 2, mb = i & 3;
                prep_item(F, CKV, 1024, b * 256 + mb * 64, 0, 512, 256, AIN(I_GCK), AIN(I_GCK), CVT + (size_t)(b * 4) * 128 * 256, (size_t)128 * 256, (size_t)2 * 128 * 256, 256, mb * 64); }
            else gla_a_item(F, it - 784, PROJ, AIN(I_WGK2), AIN(I_BGK), UT, GD, CQ, CO, H);
        }
        }
        SEAM(2);
    }
    KILL(); if (IN(3)) { REFRESH();
        REPEAT(3) {
        if (rep == 0) { gla_scan(F, UT, GD);
            asm volatile("s_waitcnt vmcnt(0)" ::: "memory"); __syncthreads();
            if (F.tid == 0) { __builtin_amdgcn_fence(__ATOMIC_RELEASE, "agent"); asm volatile("s_waitcnt vmcnt(0)" ::: "memory"); __hip_atomic_fetch_add(CTR(12), 1u, __ATOMIC_RELAXED, __HIP_MEMORY_SCOPE_AGENT); } }
        { const int xcc = (int)(__builtin_amdgcn_s_getreg((3 << 11) | 20) & 7u);
          for (int k = 0; k < 8;) { const int q = (xcc + k) & 7;
              const int i = next_item((unsigned*)(AWS + WS_BAR) + 256 + 16 * q, SLOT, F.tid);
              if (i >= 128) { ++k; continue; }
              nsa_item(F, i * 8 + q, PROJ, KC, VCT, VST, VWT, AIN(I_GQ), AIN(I_BGATE), AIN(I_GNSA), MIX, (float*)(AWS + WS_NSAO)); } }
        int it = next_item(CTR(2 + 4 * rep), SLOT, F.tid) + 1024;
        it = __builtin_amdgcn_readfirstlane(it);
        if (it < 1024 + 512) {
            if (F.tid == 0) { while (__hip_atomic_load(CTR(12), __ATOMIC_RELAXED, __HIP_MEMORY_SCOPE_AGENT) < (unsigned)F.G) __builtin_amdgcn_s_sleep(2);
                __builtin_amdgcn_fence(__ATOMIC_ACQUIRE, "agent"); asm volatile("s_waitcnt vmcnt(0)" ::: "memory"); }
            __syncthreads();
        }
        for (; it < 1024 + 512; it = next_item(CTR(2 + 4 * rep), SLOT, F.tid) + 1024) { const int task = (it - 1024) * 8 + F.wave;
            gla_c2_task(task >> 1, (task + (task >> 11)) & 1, F.lane, CQ, CO, H, UT, PROJ, AIN(I_GGLA), MIX); }
        constexpr int NLATE = (32 * 64 + 32 * 16 + 8 * 64 + 32 * 352 + 88 * 64) / 8;
        if (rep == 0) for (int it = next_item(CTR(5), SLOT, F.tid); it < NLATE; it = next_item(CTR(5), SLOT, F.tid)) {
            LAS float* scr = (LAS float*)(F.lds + F.wave * 16384); int r = it * 8 + F.wave;
            if (transpose_mat(r, AIN(I_WOUT), 2048, 2048, 2048, WT_OUT, 0, 0, scr, F.lane)) continue;
            if (transpose_mat(r, AIN(I_WCQ), 2048, 512, 512, WT_CQ, 0, 0, scr, F.lane, AIN(I_GCROSS))) continue;
            if (transpose_mat(r, AIN(I_WCO), 512, 2048, 2048, WT_CO, 0, 0, scr, F.lane)) continue;
            if (transpose_mat(r, AIN(I_WGU), 2048, 2 * DFF, 2 * DFF, WT_GU, 0, 1, scr, F.lane, AIN(I_GFFN))) continue;
            transpose_mat(r, AIN(I_WDOWN), DFF, 2048, 2048, WT_DOWN, 0, 0, scr, F.lane);
        }
        }
        SEAM(3);
    }
    KILL(); if (IN(5)) { REFRESH();
        pg8::Gemm g{MIX, WT_OUT, M, 2048, 2048}; pg8::StaticOrder S; S.init(M, 2048, F.G, F.bid); pg8::EpiResSS<true> E{AIN(I_X), XB, (float*)(AWS + WS_SS1), 2048};
        pg8::gemm_phase<pg8::EpiResSS<true>, pg8::StaticOrder, true, true>(F.lds, g, S, E, F.tid);
        SEAM(5);
    }
    KILL(); if (IN(7)) { REFRESH();
        pg8::Gemm g{XB, WT_CQ, M, 512, 2048}; pg8::StaticOrder S; S.init(M, 512, F.G, F.bid); pg8::EpiBf16 E{CQ, 512, (const float*)(AWS + WS_SS1)};
        pg8::gemm_phase<pg8::EpiBf16, pg8::StaticOrder, true, true>(F.lds, g, S, E, F.tid);
        if (F.G == 256) {
            pg8::Unit u; S.next(0, u);
            asm volatile("s_waitcnt vmcnt(0)" ::: "memory"); __syncthreads();
            for (int e = 0; e < 2; ++e) cross_item(F, ((u.pm >> 5) << 7) | ((2 * u.pn + e) << 5) | (u.pm & 31), CQ, CKV, CVT, AIN(I_GCQ), CO);
        } else { SEAM(7); }
    }
    KILL(); if (IN(8)) { REFRESH();
        if (F.G != 256) { for (int it = next_item(CTR(4), SLOT, F.tid); it < 512; it = next_item(CTR(4), SLOT, F.tid)) cross_item(F, it, CQ, CKV, CVT, AIN(I_GCQ), CO); }
        SEAM(8); }
    KILL(); if (IN(9)) { REFRESH();
        pg8::Gemm g{CO, WT_CO, M, 2048, 512}; pg8::StaticOrder S; S.init(M, 2048, F.G, F.bid); pg8::EpiResSS<false> E{XB, XB, (float*)(AWS + WS_SS2), 2048};
        pg8::gemm_phase<pg8::EpiResSS<false>, pg8::StaticOrder, true, true>(F.lds, g, S, E, F.tid);
        SEAM(9);
    }
    KILL(); if (IN(11)) { REFRESH();
        REPEAT(11) {
        pg8::Gemm g{XB, WT_GU, M, 2 * DFF, 2048}; pg8::StaticOrder S; S.init(M, 2 * DFF, F.G, F.bid); pg8::EpiSwiGLU E{HID, DFF, (const float*)(AWS + WS_SS2)};
        pg8::gemm_phase<pg8::EpiSwiGLU, pg8::StaticOrder, true, true>(F.lds, g, S, E, F.tid);
        }
        SEAM(11);
    }
    KILL(); if (IN(12)) { REFRESH();
        pg8::Gemm g{HID, WT_DOWN, M, 2048, DFF}; pg8::StaticOrder S; S.init(M, 2048, F.G, F.bid); pg8::EpiOutF32 E{XB, AOUT, 2048};
        pg8::gemm_phase<pg8::EpiOutF32, pg8::StaticOrder, true, true>(F.lds, g, S, E, F.tid);
    }
#undef IN
#undef SEAM
}

extern "C" void kernel_launch(void* const* d_in, const int* in_sizes, int n_in, void* d_out, int out_size, void* d_ws, size_t ws_size, hipStream_t stream) {
    static int grid = 0;
    if (grid == 0) {
        if (n_in != 31 || out_size != M * D || ws_size < WS_END) { fprintf(stderr, "kernel_launch: unexpected shapes n_in %d out %d ws %zu\n", n_in, out_size, ws_size); grid = -1; return; }
        int dev = 0, cus = 0, per = 0;
        (void)hipGetDevice(&dev); (void)hipDeviceGetAttribute(&cus, hipDeviceAttributeMultiprocessorCount, dev);
        (void)hipFuncSetAttribute((const void*)mega, hipFuncAttributeMaxDynamicSharedMemorySize, LDS_BYTES);
        (void)hipOccupancyMaxActiveBlocksPerMultiprocessor(&per, (const void*)mega, NT, LDS_BYTES);
        if (per < 1) per = 1;
        grid = cus * per;
        fprintf(stderr, "kernel_launch: grid %d (%d CUs x %d)\n", grid, cus, per);
    }
    if (grid < 0) return;
    (void)hipMemsetAsync((char*)d_ws + WS_BAR, 0, 4096 + 16384, stream);
    Args a{};
    for (int i = 0; i < 31; ++i) a.in[i] = (const float*)d_in[i];
    a.out = (float*)d_out; a.ws = (unsigned char*)d_ws; a.ph_lo = 0; a.ph_hi = NPHASE;
    void* args[] = {&a};
    hipError_t e = hipLaunchCooperativeKernel((const void*)mega, dim3(grid), dim3(NT), args, LDS_BYTES, stream);
    if (e != hipSuccess) fprintf(stderr, "kernel_launch: cooperative launch failed: %s (grid %d)\n", hipGetErrorString(e), grid);
}
```

```cpp
#include <hip/hip_runtime.h>
#include <hip/hip_cooperative_groups.h>
#include <cstdio>
#include <cstdint>
namespace cg = cooperative_groups;
namespace pg8 {
#define PG8_LAS __attribute__((address_space(3)))
typedef unsigned short bf16_t;
typedef short bf16x8 __attribute__((ext_vector_type(8)));
typedef float f32x4 __attribute__((ext_vector_type(4)));
typedef unsigned u32x4 __attribute__((ext_vector_type(4)));
constexpr int BM = 256, BK = 64, HALF = 128, HTB = HALF * BK * 2  , STAGE_BYTES = 8 * HTB, NXCD = 8, WGM = 8;

__host__ __device__ __forceinline__ int lds_byte(int r, int c) { const int st = (r >> 4) * 2 + (c >> 5), rr = r & 15, cc = c & 31, ob = rr * 64 + cc * 2; return st * 1024 + (ob ^ (((ob >> 9) & 1) << 5)); }
__host__ __device__ __forceinline__ void stage_rc(int b, int& R, int& C) { const int st = b / 1024, sb = b % 1024, swz = sb ^ (((sb >> 9) & 1) << 5); R = (st >> 1) * 16 + swz / 64; C = (st & 1) * 32 + (swz % 64) / 2; }
__host__ __device__ __forceinline__ int perm32(int rho) { const int n = rho >> 4, i = rho & 15; return 8 * (i >> 2) + 4 * n + (i & 3); }

struct Unit { int pm, pn; };
struct Gemm { const bf16_t* A; const bf16_t* Bt; int M, N, K; };

struct StaticOrder {
    int nM, nN, nwg, G, c;
    __host__ __device__ void init(int M, int N, int G_, int c_) { nM = M / BM; nN = N / BM; nwg = nM * nN; G = G_; c = c_; }
    __host__ __device__ bool next(int i, Unit& u) const {
        const long L = (long)i * G + c; if (L >= nwg) return false;
        int wgid = (int)L; { const int q = nwg / NXCD, r = nwg % NXCD, xcd = wgid % NXCD, off = wgid / NXCD; wgid = (xcd < r ? xcd * (q + 1) : r * (q + 1) + (xcd - r) * q) + off; }
        const int nig = WGM * nN, gid = wgid / nig, fm = gid * WGM, gsz = (nM - fm) < WGM ? (nM - fm) : WGM;
        u.pm = fm + ((wgid % nig) % gsz); u.pn = (wgid % nig) / gsz; return true;
    }
    __device__ __forceinline__ void a_ready(const Unit&) const {}
    __device__ __forceinline__ void done(const Unit&) const {}
};

__device__ __forceinline__ unsigned cvt_pk_bf16(float lo, float hi) { unsigned r; asm volatile("v_cvt_pk_bf16_f32 %0, %1, %2" : "=v"(r) : "v"(lo), "v"(hi)); return r; }
typedef float f32x2 __attribute__((ext_vector_type(2)));
typedef float f32x2_t __attribute__((ext_vector_type(2))); typedef __bf16 bf16x2_t __attribute__((ext_vector_type(2)));
__device__ __forceinline__ unsigned cvtpk(float lo, float hi) { f32x2_t v = {lo, hi}; bf16x2_t b = __builtin_convertvector(v, bf16x2_t); return __builtin_bit_cast(unsigned, b); }
struct EpiBf16 {
    static constexpr bool PERM = true, AFTER_DRAIN = false;
    bf16_t* O; int ldc; const float* ss;
    __device__ __forceinline__ void operator()(const f32x4 (&acc)[2][2][4][2], const Unit& u, int wr, int wc, int fr, int fq) const {
        const int row0 = u.pm * BM + wr * 64 + fr; const int col0 = u.pn * BM + wc * 32 + 8 * fq;
        float rsv[2][4];
#pragma unroll
        for (int ai = 0; ai < 2; ++ai)
#pragma unroll
            for (int m = 0; m < 4; ++m) rsv[ai][m] = ss ? ss[row0 + ai * HALF + m * 16] : 0.f;
        __builtin_amdgcn_sched_barrier(0);
#pragma unroll
        for (int ai = 0; ai < 2; ++ai)
#pragma unroll
            for (int m = 0; m < 4; ++m) { const int row = row0 + ai * HALF + m * 16; bf16_t* rowp = O + (size_t)row * ldc + col0;
                const float rs = ss ? __builtin_amdgcn_rsqf(rsv[ai][m] * (1.f / 2048.f) + 1e-6f) : 1.f;
#pragma unroll
                for (int bj = 0; bj < 2; ++bj) { const f32x4 v0 = acc[ai][bj][m][0] * rs, v1 = acc[ai][bj][m][1] * rs;
                    u32x4 w; w.x = cvtpk(v0[0], v0[1]); w.y = cvtpk(v0[2], v0[3]); w.z = cvtpk(v1[0], v1[1]); w.w = cvtpk(v1[2], v1[3]);
                    *(u32x4*)(rowp + bj * HALF) = w; } }
    }
};
struct EpiResF32 {
    static constexpr bool PERM = false, AFTER_DRAIN = false;
    const float* base; float* out; int ldc;
    __device__ __forceinline__ void operator()(const f32x4 (&acc)[2][2][4][2], const Unit& u, int wr, int wc, int fr, int fq) const {
        const int col0 = u.pn * BM + wc * 32 + 4 * fq;
#pragma unroll
        for (int ai = 0; ai < 2; ++ai)
#pragma unroll
            for (int m = 0; m < 4; ++m) { const size_t off = (size_t)(u.pm * BM + ai * HALF + wr * 64 + m * 16 + fr) * ldc + col0;
#pragma unroll
                for (int bj = 0; bj < 2; ++bj)
#pragma unroll
                    for (int n = 0; n < 2; ++n) { const size_t p = off + bj * HALF + n * 16; const f32x4 b = *(const f32x4*)(base + p); *(f32x4*)(out + p) = b + acc[ai][bj][m][n]; } }
    }
};
struct EpiSwiGLU {
    static constexpr bool PERM = true, AFTER_DRAIN = false;
    bf16_t* O; int ldc; const float* ss;
    static __device__ __forceinline__ float sw(float g, float u) { return g * __builtin_amdgcn_rcpf(1.0f + __expf(-g)) * u; }
    __device__ __forceinline__ void operator()(const f32x4 (&acc)[2][2][4][2], const Unit& u, int wr, int wc, int fr, int fq) const {
        const int row0 = u.pm * BM + wr * 64 + fr; const int col0 = u.pn * HALF + wc * 32 + 8 * fq;
        float rsv[2][4];
#pragma unroll
        for (int ai = 0; ai < 2; ++ai)
#pragma unroll
            for (int m = 0; m < 4; ++m) rsv[ai][m] = ss[row0 + ai * HALF + m * 16];
        __builtin_amdgcn_sched_barrier(0);
#pragma unroll
        for (int ai = 0; ai < 2; ++ai)
#pragma unroll
            for (int m = 0; m < 4; ++m) { const int row = row0 + ai * HALF + m * 16; bf16_t* rowp = O + (size_t)row * ldc + col0;
                const float rs = __builtin_amdgcn_rsqf(rsv[ai][m] * (1.f / 2048.f) + 1e-6f);
                const f32x4 g0 = acc[ai][0][m][0] * rs, g1 = acc[ai][0][m][1] * rs, u0 = acc[ai][1][m][0] * rs, u1 = acc[ai][1][m][1] * rs;
                u32x4 w; w.x = cvtpk(sw(g0[0], u0[0]), sw(g0[1], u0[1])); w.y = cvtpk(sw(g0[2], u0[2]), sw(g0[3], u0[3]));
                w.z = cvtpk(sw(g1[0], u1[0]), sw(g1[1], u1[1])); w.w = cvtpk(sw(g1[2], u1[2]), sw(g1[3], u1[3]));
                *(u32x4*)rowp = w; }
    }
};

__device__ __forceinline__ float bfl(unsigned w) { return __uint_as_float(w << 16); }
__device__ __forceinline__ float bfh(unsigned w) { return __uint_as_float(w & 0xffff0000u); }
template <bool BASE_F32> struct EpiResSS {
    static constexpr bool PERM = true, AFTER_DRAIN = false;
    const void* base; bf16_t* XB; float* ss; int ldc;
    __device__ __forceinline__ void operator()(const f32x4 (&acc)[2][2][4][2], const Unit& u, int wr, int wc, int fr, int fq) const {
        const int row0 = u.pm * BM + wr * 64 + fr; const int col0 = u.pn * BM + wc * 32 + 8 * fq;
#pragma unroll
        for (int ai = 0; ai < 2; ++ai) {
            f32x4 pb0[4][2], pb1[4][2]; u32x4 pw[4][2];
#pragma unroll
            for (int m = 0; m < 4; ++m)
#pragma unroll
                for (int bj = 0; bj < 2; ++bj) { const size_t off = (size_t)(row0 + ai * HALF + m * 16) * ldc + col0 + bj * HALF;
                    if (BASE_F32) { pb0[m][bj] = *(const f32x4*)((const float*)base + off); pb1[m][bj] = *(const f32x4*)((const float*)base + off + 4); }
                    else pw[m][bj] = *(const u32x4*)((const bf16_t*)base + off); }
            __builtin_amdgcn_sched_barrier(0);
#pragma unroll
            for (int m = 0; m < 4; ++m) { const int row = row0 + ai * HALF + m * 16; float sq = 0.f;
#pragma unroll
                for (int bj = 0; bj < 2; ++bj) { const size_t off = (size_t)row * ldc + col0 + bj * HALF; f32x4 b0, b1;
                    if (BASE_F32) { b0 = pb0[m][bj]; b1 = pb1[m][bj]; }
                    else { const u32x4 w = pw[m][bj]; b0 = (f32x4){bfl(w.x), bfh(w.x), bfl(w.y), bfh(w.y)}; b1 = (f32x4){bfl(w.z), bfh(w.z), bfl(w.w), bfh(w.w)}; }
                    const f32x4 v0 = b0 + acc[ai][bj][m][0], v1 = b1 + acc[ai][bj][m][1];
                    u32x4 o; o.x = cvtpk(v0[0], v0[1]); o.y = cvtpk(v0[2], v0[3]); o.z = cvtpk(v1[0], v1[1]); o.w = cvtpk(v1[2], v1[3]);
                    *(u32x4*)(XB + off) = o;
                    sq += (bfl(o.x) * bfl(o.x) + bfh(o.x) * bfh(o.x)) + (bfl(o.y) * bfl(o.y) + bfh(o.y) * bfh(o.y)) + (bfl(o.z) * bfl(o.z) + bfh(o.z) * bfh(o.z)) + (bfl(o.w) * bfl(o.w) + bfh(o.w) * bfh(o.w)); }
                sq += __shfl_xor(sq, 16); sq += __shfl_xor(sq, 32);
                if (fq == 0) atomicAdd(ss + row, sq); }
            __builtin_amdgcn_sched_barrier(0);
        }
    }
};
struct EpiOutF32 {
    static constexpr bool PERM = true, AFTER_DRAIN = false;
    const bf16_t* XB; float* out; int ldc;
    __device__ __forceinline__ void operator()(const f32x4 (&acc)[2][2][4][2], const Unit& u, int wr, int wc, int fr, int fq) const {
        const int row0 = u.pm * BM + wr * 64 + fr; const int col0 = u.pn * BM + wc * 32 + 8 * fq;
#pragma unroll
        for (int ai = 0; ai < 2; ++ai) {
            u32x4 pw[4][2];
#pragma unroll
            for (int m = 0; m < 4; ++m)
#pragma unroll
                for (int bj = 0; bj < 2; ++bj) pw[m][bj] = *(const u32x4*)(XB + (size_t)(row0 + ai * HALF + m * 16) * ldc + col0 + bj * HALF);
            __builtin_amdgcn_sched_barrier(0);
#pragma unroll
            for (int m = 0; m < 4; ++m)
#pragma unroll
                for (int bj = 0; bj < 2; ++bj) { const size_t off = (size_t)(row0 + ai * HALF + m * 16) * ldc + col0 + bj * HALF;
                    const u32x4 w = pw[m][bj];
                    *(f32x4*)(out + off) = (f32x4){bfl(w.x), bfh(w.x), bfl(w.y), bfh(w.y)} + acc[ai][bj][m][0];
                    *(f32x4*)(out + off + 4) = (f32x4){bfl(w.z), bfh(w.z), bfl(w.w), bfh(w.w)} + acc[ai][bj][m][1]; }
            __builtin_amdgcn_sched_barrier(0);
        }
    }
};
template <class Epi, class Sched, bool ALIGN_EPI = false, bool SP2 = false>
__device__ __forceinline__ void gemm_phase(PG8_LAS unsigned char* lds, const Gemm g, const Sched& S, const Epi& E, const int tid_in) {
    const int tid = tid_in, wid = __builtin_amdgcn_readfirstlane(tid >> 6), lane = tid & 63, wr = wid >> 2, wc = wid & 3, fr = lane & 15, fq = lane >> 4;
    const int K = g.K, nt = K / BK;
    unsigned voffA[2], voffB[2];
#pragma unroll
    for (int i = 0; i < 2; ++i) { int R, C; stage_rc(tid * 16 + i * 8192, R, C); const int Rb = Epi::PERM ? ((R & ~31) + perm32(R & 31)) : R;
        voffA[i] = (unsigned)(R * K + C) * 2u; voffB[i] = (unsigned)(Rb * K + C) * 2u; }
    const size_t kstep = (size_t)(BK * 2);
    const size_t hstep = (size_t)HALF * K * 2;
    const size_t tstep = 2 * hstep;
    const unsigned ldsw = (unsigned)wid * 1024u;
    const int aoff = lds_byte(wr * 64 + fr, fq * 8), boff = lds_byte(wc * 32 + fr, fq * 8);
#define PG8_SA(b, h) (((b) * 2 + (h)) * HTB)
#define PG8_SB(b, h) ((4 + (b) * 2 + (h)) * HTB)
#define PG8_STAGE(bufoff, gbase, voff) do { _Pragma("unroll") for (int _i = 0; _i < 2; ++_i) \
        __builtin_amdgcn_global_load_lds((const unsigned*)((const char*)(gbase) + (voff)[_i]), (PG8_LAS unsigned*)(lds + (bufoff) + ldsw + _i * 8192), 16, 0, 0); } while (0)
#define PG8_LDA(dst, b, h) do { _Pragma("unroll") for (int m = 0; m < 4; ++m) _Pragma("unroll") for (int k = 0; k < 2; ++k) dst[m][k] = *(const PG8_LAS bf16x8*)(lds + PG8_SA(b, h) + aoff + m * 2048 + k * 1024); } while (0)
#define PG8_LDB(dst, b, h) do { _Pragma("unroll") for (int n = 0; n < 2; ++n) _Pragma("unroll") for (int k = 0; k < 2; ++k) dst[n][k] = *(const PG8_LAS bf16x8*)(lds + PG8_SB(b, h) + boff + n * 2048 + k * 1024); } while (0)
#define PG8_MMA(ai, bj, At, Bt) do { __builtin_amdgcn_s_setprio(1); _Pragma("unroll") for (int m = 0; m < 4; ++m) _Pragma("unroll") for (int n = 0; n < 2; ++n) _Pragma("unroll") for (int k = 0; k < 2; ++k) \
        acc[ai][bj][m][n] = __builtin_amdgcn_mfma_f32_16x16x32_bf16(Bt[n][k], At[m][k], acc[ai][bj][m][n], 0, 0, 0); __builtin_amdgcn_s_setprio(0); } while (0)
#define PG8_WAIT_V(n) asm volatile("s_waitcnt vmcnt(" #n ")" ::: "memory")
#define PG8_WAIT_L(n) asm volatile("s_waitcnt lgkmcnt(" #n ")" ::: "memory")
#define PG8_BAR __builtin_amdgcn_s_barrier()
#define PG8_SCHED __builtin_amdgcn_sched_barrier(0)
    Unit cur, nxt; int ui = 0;
    if (!S.next(0, cur)) return;
    f32x4 acc[2][2][4][2];
#pragma unroll
    for (int a = 0; a < 2; ++a)
#pragma unroll
        for (int b = 0; b < 2; ++b)
#pragma unroll
            for (int m = 0; m < 4; ++m)
#pragma unroll
                for (int n = 0; n < 2; ++n) acc[a][b][m][n] = (f32x4){0.f, 0.f, 0.f, 0.f};
    bf16x8 At[4][2], B0[2][2], B1[2][2];
    const char* cA = (const char*)g.A + (size_t)cur.pm * tstep; const char* cB = (const char*)g.Bt + (size_t)cur.pn * tstep;
    S.a_ready(cur);
    if constexpr (SP2) {
        PG8_STAGE(PG8_SB(0, 0), cB, voffB); PG8_STAGE(PG8_SB(0, 1), cB + hstep, voffB); PG8_STAGE(PG8_SA(0, 0), cA, voffA); PG8_STAGE(PG8_SA(0, 1), cA + hstep, voffA);
        if (wr == 1) PG8_BAR;
        PG8_WAIT_V(2); PG8_BAR;
        PG8_STAGE(PG8_SB(1, 0), cB + kstep, voffB); PG8_STAGE(PG8_SA(1, 0), cA + kstep, voffA); PG8_STAGE(PG8_SB(1, 1), cB + hstep + kstep, voffB);
        PG8_WAIT_V(6); PG8_BAR;
    } else {
        PG8_STAGE(PG8_SB(0, 0), cB, voffB); PG8_STAGE(PG8_SA(0, 0), cA, voffA); PG8_STAGE(PG8_SB(0, 1), cB + hstep, voffB); PG8_STAGE(PG8_SA(0, 1), cA + hstep, voffA);
        if (wr == 1) PG8_BAR;
        PG8_WAIT_V(4); PG8_BAR;
        PG8_STAGE(PG8_SB(1, 0), cB + kstep, voffB); PG8_STAGE(PG8_SA(1, 0), cA + kstep, voffA); PG8_STAGE(PG8_SB(1, 1), cB + hstep + kstep, voffB);
        PG8_WAIT_V(6); PG8_BAR;
    }
    for (;;) {
        const bool has_next = S.next(ui + 1, nxt);
        const char* nA = has_next ? (const char*)g.A + (size_t)nxt.pm * tstep : cA; const char* nB = has_next ? (const char*)g.Bt + (size_t)nxt.pn * tstep : cB;
        for (int t = 0; t < nt; t += 2) {
            const bool last = (t == nt - 2);
            const char* a1 = cA + (size_t)(t + 1) * kstep;
            const char* a2 = last ? nA : cA + (size_t)(t + 2) * kstep; const char* b2 = last ? nB : cB + (size_t)(t + 2) * kstep;
            const char* a3 = a2 + kstep; const char* b3 = b2 + kstep;
            if (last && has_next) S.a_ready(nxt);
            if constexpr (SP2) {
            PG8_LDB(B0, 0, 0); PG8_LDB(B1, 0, 1); PG8_SCHED; PG8_LDA(At, 0, 0); PG8_STAGE(PG8_SA(1, 1), a1 + hstep, voffA);
            PG8_WAIT_V(8); PG8_WAIT_L(0); PG8_BAR; PG8_MMA(0, 0, At, B0); PG8_MMA(0, 1, At, B1); PG8_BAR; PG8_SCHED;
            PG8_LDA(At, 0, 1); PG8_STAGE(PG8_SB(0, 0), b2, voffB); PG8_STAGE(PG8_SB(0, 1), b2 + hstep, voffB); PG8_STAGE(PG8_SA(0, 0), a2, voffA);
            PG8_WAIT_V(8); PG8_WAIT_L(0); PG8_BAR; PG8_MMA(1, 0, At, B0); PG8_MMA(1, 1, At, B1); PG8_BAR; PG8_SCHED;
            PG8_LDB(B0, 1, 0); PG8_LDB(B1, 1, 1); PG8_SCHED; PG8_LDA(At, 1, 0); PG8_STAGE(PG8_SA(0, 1), a2 + hstep, voffA);
            PG8_WAIT_V(8); PG8_WAIT_L(0); PG8_BAR; PG8_MMA(0, 0, At, B0); PG8_MMA(0, 1, At, B1); PG8_BAR; PG8_SCHED;
            PG8_LDA(At, 1, 1); PG8_STAGE(PG8_SB(1, 0), b3, voffB); PG8_STAGE(PG8_SB(1, 1), b3 + hstep, voffB); PG8_STAGE(PG8_SA(1, 0), a3, voffA);
            PG8_WAIT_V(8); PG8_WAIT_L(0); PG8_BAR; PG8_MMA(1, 0, At, B0); PG8_MMA(1, 1, At, B1); PG8_BAR; PG8_SCHED;
            } else {
            PG8_LDB(B0, 0, 0); PG8_SCHED; PG8_LDA(At, 0, 0); PG8_STAGE(PG8_SA(1, 1), a1 + hstep, voffA);
            PG8_WAIT_L(8); PG8_BAR; PG8_WAIT_L(0); PG8_MMA(0, 0, At, B0); PG8_BAR; PG8_SCHED;
            PG8_LDB(B1, 0, 1); PG8_STAGE(PG8_SB(0, 0), b2, voffB);
            PG8_BAR; PG8_WAIT_L(0); PG8_MMA(0, 1, At, B1); PG8_BAR;
            PG8_LDA(At, 0, 1); PG8_STAGE(PG8_SA(0, 0), a2, voffA);
            PG8_BAR; PG8_WAIT_L(0); PG8_MMA(1, 0, At, B0); PG8_BAR; PG8_SCHED;
            PG8_STAGE(PG8_SB(0, 1), b2 + hstep, voffB);
            PG8_WAIT_V(6); PG8_BAR; PG8_MMA(1, 1, At, B1); PG8_BAR;
            PG8_LDB(B0, 1, 0); PG8_SCHED; PG8_LDA(At, 1, 0); PG8_STAGE(PG8_SA(0, 1), a2 + hstep, voffA);
            PG8_WAIT_L(8); PG8_BAR; PG8_WAIT_L(0); PG8_MMA(0, 0, At, B0); PG8_BAR; PG8_SCHED;
            PG8_LDB(B1, 1, 1); PG8_STAGE(PG8_SB(1, 0), b3, voffB);
            PG8_BAR; PG8_WAIT_L(0); PG8_MMA(0, 1, At, B1); PG8_BAR;
            PG8_LDA(At, 1, 1); PG8_STAGE(PG8_SA(1, 0), a3, voffA);
            PG8_BAR; PG8_WAIT_L(0); PG8_MMA(1, 0, At, B0); PG8_BAR; PG8_SCHED;
            PG8_STAGE(PG8_SB(1, 1), b3 + hstep, voffB);
            PG8_WAIT_V(6); PG8_BAR; PG8_MMA(1, 1, At, B1); PG8_BAR;
            }
        }
        if constexpr (ALIGN_EPI) { if (wr == 0) PG8_BAR; }
        if constexpr (!Epi::AFTER_DRAIN) { E(acc, cur, wr, wc, fr, fq); S.done(cur); }
        if (!has_next) break;
#pragma unroll
        for (int a = 0; a < 2; ++a)
#pragma unroll
            for (int b = 0; b < 2; ++b)
#pragma unroll
                for (int m = 0; m < 4; ++m)
#pragma unroll
                    for (int n = 0; n < 2; ++n) acc[a][b][m][n] = (f32x4){0.f, 0.f, 0.f, 0.f};
        cur = nxt; cA = nA; cB = nB; ++ui;
        if constexpr (ALIGN_EPI) { if (wr == 1) PG8_BAR; }
    }
    PG8_WAIT_V(0);
    if constexpr (!ALIGN_EPI) { if (wr == 0) PG8_BAR; }
    PG8_BAR;
    if constexpr (Epi::AFTER_DRAIN) { E.fused(acc, cur, wr, wc, fr, fq, lds, wid, lane); S.done(cur); }
#undef PG8_SA
#undef PG8_SB
#undef PG8_STAGE
#undef PG8_LDA
#undef PG8_LDB
#undef PG8_MMA
#undef PG8_WAIT_V
#undef PG8_WAIT_L
#undef PG8_BAR
#undef PG8_SCHED
}
}
#define DI __device__ __forceinline__
#define LAS __attribute__((address_space(3)))
typedef unsigned short bf16;
typedef short bf16x8 __attribute__((ext_vector_type(8)));
typedef short s16x4 __attribute__((ext_vector_type(4)));
typedef float f32x4 __attribute__((ext_vector_type(4)));
typedef unsigned u32x4 __attribute__((ext_vector_type(4)));
typedef unsigned u32x2 __attribute__((ext_vector_type(2)));
constexpr int NWAVES = 8, NT = 512;
constexpr int Bn = 4, T = 8192, D = 2048, M = Bn * T;
constexpr int MEM = 256, MM = Bn * MEM;
constexpr int DIN = 5672, LDP = 5888;
constexpr int DFF = 5632;
constexpr float EPS = 1e-6f;
constexpr int C_Q = 0, C_KC = 1024, C_VC = 1280, C_KS = 1536, C_VS = 1792, C_KW = 2048, C_VW = 2304, C_GATE = 2560,
              C_QL = 2584, C_KL = 3096, C_VL = 3608, C_AL = 4632, C_RL = 4648;
constexpr int NCMP = 511, NSEL = 128;
constexpr size_t MiB = 1u << 20;
constexpr size_t WS_SS1 = 0, WS_SS2 = 262144, WS_BAR = 786432, WS_WT_IN = 1 * MiB, WS_WT_OUT = 25 * MiB, WS_WT_CQ = 33 * MiB, WS_WT_CKV = 35 * MiB, WS_WT_CO = 39 * MiB, WS_WT_GU = 41 * MiB,
                 WS_WT_DOWN = 85 * MiB, WS_WT_C1K = 107 * MiB, WS_WT_C1V = 109 * MiB, WS_WT_C2K = 111 * MiB, WS_WT_C2V = 111 * MiB + 65536,
                 WS_HM = 112 * MiB, WS_CKV = 116 * MiB, WS_CVT = 118 * MiB, WS_KC = 119 * MiB, WS_VCT = 120 * MiB, WS_GD = 121 * MiB,
                 WS_VST = 122 * MiB, WS_VWT = 138 * MiB, WS_CQ = 154 * MiB, WS_CO = 186 * MiB, WS_H = 218 * MiB, WS_MIX = 346 * MiB,
                 WS_UT = 474 * MiB, WS_PROJ = 602 * MiB, WS_HID = 602 * MiB, WS_NSAO = 970 * MiB, WS_END = 1002 * MiB;
constexpr int LDS_BYTES = 147456;

DI float bf2f(unsigned v) { return __uint_as_float(v << 16); }
DI float bflo(unsigned w) { return __uint_as_float(w << 16); }
DI float bfhi(unsigned w) { return __uint_as_float(w & 0xffff0000u); }
DI unsigned pk2(float lo, float hi) { return pg8::cvtpk(lo, hi); }
DI bf16 f2bf(float f) { return (bf16)(pg8::cvtpk(f, 0.f) & 0xffffu); }
DI float wave_sum(float v) {
#pragma unroll
    for (int o = 1; o < 64; o <<= 1) v += __shfl_xor(v, o);
    return v;
}
DI float silu_f(float g) { return g * __builtin_amdgcn_rcpf(1.0f + __expf(-g)); }
#define MFMA16(a, b, c) __builtin_amdgcn_mfma_f32_16x16x32_bf16((a), (b), (c), 0, 0, 0)

struct Frame {
    LAS unsigned char* lds;
    int tid, lane, wave, G, bid;
    const float* const* in;
};

DI void transpose_item(const float* W, int K, int Nsrc, bf16* WT, int dst_row0, int srcc0, int k0, LAS float* scr, int lane, const float* kg) {
#pragma unroll 8
    for (int i = 0; i < 32; ++i) { const int kk = 2 * i + (lane >> 5); const int sc = srcc0 + (lane & 31);
        scr[kk * 33 + (lane & 31)] = (sc < Nsrc) ? W[(size_t)(k0 + kk) * Nsrc + sc] * (kg ? kg[k0 + kk] : 1.f) : 0.f; }
    asm volatile("s_waitcnt lgkmcnt(0)" ::: "memory");
    const int c = lane & 7;
#pragma unroll
    for (int j = 0; j < 4; ++j) { const int n = (lane >> 3) + 8 * j; const LAS float* s = scr + (8 * c) * 33 + n;
        u32x4 o; o.x = pk2(s[0 * 33], s[1 * 33]); o.y = pk2(s[2 * 33], s[3 * 33]); o.z = pk2(s[4 * 33], s[5 * 33]); o.w = pk2(s[6 * 33], s[7 * 33]);
        *(u32x4*)(WT + (size_t)(dst_row0 + n) * K + k0 + 8 * c) = o; }
    asm volatile("s_waitcnt lgkmcnt(0)" ::: "memory");
}
DI bool transpose_mat(int& r, const float* W, int K, int Nsrc, int Ndst, bf16* WT, int row_off, int mode, LAS float* scr, int lane, const float* kg = nullptr) {
    const int nblk = Ndst / 32, items = (K / 64) * nblk;
    if (r >= items) { r -= items; return false; }
    const int kb = r / nblk, nb = r % nblk, n0 = 32 * nb;
    int sc = n0;
    if (mode == 1) sc = ((n0 & 255) >> 7) * DFF + (n0 >> 8) * 128 + (n0 & 127);
    transpose_item(W, K, Nsrc, WT, row_off + n0, sc, 64 * kb, scr, lane, kg);
    return true;
}
DI void rms_row_to_bf16(const float* xrow, const float* g, bf16* orow, int lane) {
    const f32x4* xr = (const f32x4*)xrow + lane; const f32x4* gr = (const f32x4*)g + lane;
    f32x4 v[8], gv[8]; float s = 0.f;
#pragma unroll
    for (int j = 0; j < 8; ++j) { v[j] = xr[64 * j]; gv[j] = gr[64 * j]; }
    __builtin_amdgcn_sched_barrier(0);
#pragma unroll
    for (int j = 0; j < 8; ++j) s += (v[j].x * v[j].x + v[j].y * v[j].y) + (v[j].z * v[j].z + v[j].w * v[j].w);
    const float rstd = __builtin_amdgcn_rsqf(wave_sum(s) * (1.f / D) + EPS);
    u32x2* o8 = (u32x2*)orow + lane;
#pragma unroll
    for (int j = 0; j < 8; ++j) { const f32x4 gg = gv[j]; u32x2 w; w.x = pk2(v[j].x * rstd * gg.x, v[j].y * rstd * gg.y); w.y = pk2(v[j].z * rstd * gg.z, v[j].w * rstd * gg.w); o8[64 * j] = w; }
}
DI void rms_rows_phase(const Frame& F, const float* src, const float* g, bf16* dst, int nrows) {
    const int gw = F.bid * NWAVES + F.wave, NGW = F.G * NWAVES;
    for (int m = gw; m < nrows; m += NGW) rms_row_to_bf16(src + (size_t)m * D, g, dst + (size_t)m * D, F.lane);
}
DI void prep_item(const Frame& F, bf16* src, int ld, int rowbase, int kbase, int vbase, int kstep, const float* g0, const float* g1,
                  bf16* vd, size_t vstep1, size_t vstep2, int vld, int vcoff) {
    LAS bf16* Tt = (LAS bf16*)F.lds;
#pragma unroll
    for (int i = 0; i < 8; ++i) { const int idx = F.tid + NT * i, w = idx >> 10, row = (idx >> 4) & 63, ch = idx & 15;
        const u32x4 v = *(const u32x4*)(src + (size_t)(rowbase + row) * ld + vbase + (w >> 1) * kstep + (w & 1) * 128 + ch * 8);
        *(LAS u32x4*)(Tt + (w * 64 + row) * 136 + ch * 8) = v; }
    {
        unsigned uv[32];
        unsigned* pb = (unsigned*)(src + (size_t)(rowbase + F.wave * 8) * ld + kbase) + F.lane;
#pragma unroll
        for (int it = 0; it < 32; ++it) uv[it] = pb[((size_t)(it >> 2) * ld + ((it >> 1) & 1) * kstep + (it & 1) * 128) >> 1];
        const float ga0 = g0[2 * F.lane], ga1 = g0[2 * F.lane + 1], gb0 = g1[2 * F.lane], gb1 = g1[2 * F.lane + 1];
        __builtin_amdgcn_sched_barrier(0);
#pragma unroll
        for (int it = 0; it < 32; ++it) { const float a = bflo(uv[it]), b = bfhi(uv[it]);
            const float rstd = __builtin_amdgcn_rsqf(wave_sum(a * a + b * b) * (1.f / 128.f) + EPS);
            pb[((size_t)(it >> 2) * ld + ((it >> 1) & 1) * kstep + (it & 1) * 128) >> 1] = (it & 2) ? pk2(a * rstd * gb0, b * rstd * gb1) : pk2(a * rstd * ga0, b * rstd * ga1); }
    }
    __syncthreads();
#pragma unroll
    for (int i = 0; i < 8; ++i) { const int idx = F.tid + NT * i, w = idx >> 10, tch = (idx >> 7) & 7, dv = idx & 127;
        const LAS bf16* s = Tt + (w * 64 + tch * 8) * 136 + dv;
        u32x4 o; o.x = (unsigned)s[0] | ((unsigned)s[136] << 16); o.y = (unsigned)s[2 * 136] | ((unsigned)s[3 * 136] << 16);
        o.z = (unsigned)s[4 * 136] | ((unsigned)s[5 * 136] << 16); o.w = (unsigned)s[6 * 136] | ((unsigned)s[7 * 136] << 16);
        *(u32x4*)(vd + (w >> 1) * vstep2 + (w & 1) * vstep1 + (size_t)dv * vld + vcoff + tch * 8) = o; }
    __syncthreads();
}

DI void compress_item(const Frame& F, int item, const bf16* PROJ, const float* pe_k, const float* pe_v, const bf16* w1k, const bf16* w1v,
                      const bf16* w2k, const bf16* w2v, const float* g_kc, bf16* KC, bf16* VCT) {
    const int kv = item & 1, itile = (item >> 1) & 15, kvh = (item >> 5) & 1, b = item >> 6;
    const float* pe = kv ? pe_v : pe_k; const bf16* W1 = kv ? w1v : w1k; const bf16* W2 = kv ? w2v : w2k;
    const int cbase = (kv ? C_VC : C_KC) + kvh * 128;
    const int r = F.lane & 15, quad = F.lane >> 4;
    LAS bf16* Hs = (LAS bf16*)F.lds;
    LAS float* red = (LAS float*)(F.lds + 32 * 264 * 2);
    int I0 = itile * 32 + r, I1 = I0 + 16; if (I0 > 510) I0 = 510; if (I1 > 510) I1 = 510;
    const bf16* a0p = PROJ + (size_t)(b * T + 16 * I0) * LDP + cbase + quad * 8;
    const bf16* a1p = PROJ + (size_t)(b * T + 16 * I1) * LDP + cbase + quad * 8;
    const bf16* b0p = W1 + (size_t)(F.wave * 32 + r) * 4096 + quad * 8;
    const bf16* b1p = b0p + (size_t)16 * 4096;
    f32x4 acc[2][2];
#pragma unroll
    for (int i = 0; i < 2; ++i)
#pragma unroll
        for (int j = 0; j < 2; ++j) acc[i][j] = (f32x4){0.f, 0.f, 0.f, 0.f};
#pragma unroll 1
    for (int l = 0; l < 32; ++l) {
        f32x4 pv[4][2]; u32x4 xa[4], xb[4]; bf16x8 wa[4], wb[4];
#pragma unroll
        for (int q = 0; q < 4; ++q) {
            pv[q][0] = *(const f32x4*)(pe + l * 128 + q * 32 + quad * 8); pv[q][1] = *(const f32x4*)(pe + l * 128 + q * 32 + quad * 8 + 4);
            xa[q] = *(const u32x4*)(a0p + (size_t)l * LDP + q * 32); xb[q] = *(const u32x4*)(a1p + (size_t)l * LDP + q * 32);
            wa[q] = *(const bf16x8*)(b0p + (l * 4 + q) * 32); wb[q] = *(const bf16x8*)(b1p + (l * 4 + q) * 32); }
        __builtin_amdgcn_sched_barrier(0);
#pragma unroll
        for (int q = 0; q < 4; ++q) {
            const f32x4 p0 = pv[q][0], p1 = pv[q][1]; const u32x4 x0 = xa[q], x1 = xb[q];
            u32x4 y0, y1;
            y0.x = pk2(bflo(x0.x) + p0.x, bfhi(x0.x) + p0.y); y0.y = pk2(bflo(x0.y) + p0.z, bfhi(x0.y) + p0.w);
            y0.z = pk2(bflo(x0.z) + p1.x, bfhi(x0.z) + p1.y); y0.w = pk2(bflo(x0.w) + p1.z, bfhi(x0.w) + p1.w);
            y1.x = pk2(bflo(x1.x) + p0.x, bfhi(x1.x) + p0.y); y1.y = pk2(bflo(x1.y) + p0.z, bfhi(x1.y) + p0.w);
            y1.z = pk2(bflo(x1.z) + p1.x, bfhi(x1.z) + p1.y); y1.w = pk2(bflo(x1.w) + p1.z, bfhi(x1.w) + p1.w);
            const bf16x8 a0 = __builtin_bit_cast(bf16x8, y0), a1 = __builtin_bit_cast(bf16x8, y1);
            acc[0][0] = MFMA16(a0, wa[q], acc[0][0]); acc[0][1] = MFMA16(a0, wb[q], acc[0][1]);
            acc[1][0] = MFMA16(a1, wa[q], acc[1][0]); acc[1][1] = MFMA16(a1, wb[q], acc[1][1]);
        }
        __builtin_amdgcn_sched_barrier(0);
    }
#pragma unroll
    for (int mt = 0; mt < 2; ++mt)
#pragma unroll
        for (int nt = 0; nt < 2; ++nt)
#pragma unroll
            for (int j = 0; j < 4; ++j) Hs[(mt * 16 + quad * 4 + j) * 264 + F.wave * 32 + nt * 16 + r] = f2bf(silu_f(acc[mt][nt][j]));
    __syncthreads();
    f32x4 acc2[2] = {(f32x4){0.f, 0.f, 0.f, 0.f}, (f32x4){0.f, 0.f, 0.f, 0.f}};
#pragma unroll
    for (int ks = 0; ks < 8; ++ks) {
        const bf16x8 bb = *(const bf16x8*)(W2 + (size_t)(F.wave * 16 + r) * 256 + ks * 32 + quad * 8);
#pragma unroll
        for (int mt = 0; mt < 2; ++mt) { const bf16x8 a = *(const LAS bf16x8*)(Hs + (mt * 16 + r) * 264 + ks * 32 + quad * 8); acc2[mt] = MFMA16(a, bb, acc2[mt]); }
    }
#pragma unroll
    for (int mt = 0; mt < 2; ++mt)
#pragma unroll
        for (int j = 0; j < 4; ++j) { float s = acc2[mt][j] * acc2[mt][j];
            s += __shfl_xor(s, 1); s += __shfl_xor(s, 2); s += __shfl_xor(s, 4); s += __shfl_xor(s, 8);
            if (r == 0) red[(mt * 16 + quad * 4 + j) * 8 + F.wave] = s; }
    __syncthreads();
    const int col = F.wave * 16 + r; const float gk = g_kc[col];
#pragma unroll
    for (int mt = 0; mt < 2; ++mt)
#pragma unroll
        for (int j = 0; j < 4; ++j) { const int row = mt * 16 + quad * 4 + j, I = itile * 32 + row;
            float ss = 0.f;
#pragma unroll
            for (int w = 0; w < 8; ++w) ss += red[row * 8 + w];
            const float rstd = __builtin_amdgcn_rsqf(ss * (1.f / 128.f) + EPS);
            const bool valid = I < NCMP;
            if (kv == 0) KC[((size_t)(b * 2 + kvh) * 512 + I) * 128 + col] = valid ? f2bf(acc2[mt][j] * rstd * gk) : (bf16)0;
            else VCT[((size_t)(b * 2 + kvh) * 128 + col) * 512 + I] = valid ? f2bf(acc2[mt][j]) : (bf16)0; }
    __syncthreads();
}
DI void gla_chunk_b(const Frame& F, const bf16* PROJ, const float* w_gk2, const float* b_gk, int b, int h, int c, LAS float* LB, LAS float* As, LAS float* Ps) {
    const size_t row0 = (size_t)b * T + (size_t)c * 64;
    if (F.tid < 128) { const int j = F.tid >> 1, hh = F.tid & 1; const u32x4 x = *(const u32x4*)(PROJ + (row0 + j) * LDP + C_AL + hh * 8); LAS float* ap = As + j * 16 + hh * 8;
        ap[0] = bflo(x.x); ap[1] = bfhi(x.x); ap[2] = bflo(x.y); ap[3] = bfhi(x.y); ap[4] = bflo(x.z); ap[5] = bfhi(x.z); ap[6] = bflo(x.w); ap[7] = bfhi(x.w); }
    const int d = F.tid & 127, part = F.tid >> 7;
    float w[16];
#pragma unroll
    for (int rr = 0; rr < 16; ++rr) w[rr] = w_gk2[rr * 512 + h * 128 + d];
    const float bias = b_gk[h * 128 + d];
    __builtin_amdgcn_sched_barrier(0);
    __syncthreads();
    float run = 0.f;
#pragma unroll 4
    for (int jj = 0; jj < 16; ++jj) { const int j = part * 16 + jj; float x = bias;
#pragma unroll
        for (int rr = 0; rr < 16; ++rr) x += As[j * 16 + rr] * w[rr];
        const float la = (fminf(x, 0.f) - log1pf(__expf(-fabsf(x)))) * (1.f / 16.f);
        run += la; LB[j * 128 + d] = run; }
    Ps[part * 128 + d] = run;
    __syncthreads();
    float pre = 0.f;
#pragma unroll
    for (int p = 0; p < 3; ++p) if (p < part) pre += Ps[p * 128 + d];
#pragma unroll
    for (int jj = 0; jj < 16; ++jj) LB[(part * 16 + jj) * 128 + d] += pre;
    __syncthreads();
}
constexpr int GL_LB = 0, GL_AS = 32768, GL_PS = 36864, GL_X = 38912;
DI void gla_a_item(const Frame& F, int item, const bf16* PROJ, const float* w_gk2, const float* b_gk, bf16* UT, float* GD, bf16* QT, bf16* KT, bf16* VTG) {
    const int c = item & 127, h = (item >> 7) & 3, b = item >> 9;
    LAS float* LB = (LAS float*)(F.lds + GL_LB); LAS float* As = (LAS float*)(F.lds + GL_AS); LAS float* Ps = (LAS float*)(F.lds + GL_PS);
    LAS bf16* KH = (LAS bf16*)(F.lds + GL_X);
    LAS bf16* Vt = (LAS bf16*)(F.lds + GL_X + 18432);
    const size_t row0 = (size_t)b * T + (size_t)c * 64;
    const bf16* tp = PROJ + (row0 + (F.tid >> 3)) * LDP + (F.tid & 7) * 16;
    const u32x4 hk0 = *(const u32x4*)(tp + C_KL + h * 128), hk1 = *(const u32x4*)(tp + C_KL + h * 128 + 8);
    const u32x4 hq0 = *(const u32x4*)(tp + C_QL + h * 128), hq1 = *(const u32x4*)(tp + C_QL + h * 128 + 8);
    u32x4 hv[4];
#pragma unroll
    for (int q = 0; q < 4; ++q) hv[q] = *(const u32x4*)(tp + (F.tid & 7) * 16 + C_VL + h * 256 + q * 8);
    __builtin_amdgcn_sched_barrier(0);
    gla_chunk_b(F, PROJ, w_gk2, b_gk, b, h, c, LB, As, Ps);
    { const int j = F.tid >> 3, d0 = (F.tid & 7) * 16; const bf16* kp = PROJ + (row0 + j) * LDP + C_KL + h * 128 + d0;
      const u32x4 x0 = hk0, x1 = hk1;
      const unsigned xw[8] = {x0.x, x0.y, x0.z, x0.w, x1.x, x1.y, x1.z, x1.w};
#pragma unroll
      for (int q = 0; q < 8; ++q) { const int d = d0 + 2 * q;
          KH[d * 72 + j] = f2bf(bflo(xw[q]) * __expf(LB[63 * 128 + d] - LB[j * 128 + d]));
          KH[(d + 1) * 72 + j] = f2bf(bfhi(xw[q]) * __expf(LB[63 * 128 + d + 1] - LB[j * 128 + d + 1])); }
      if (F.tid < 128) GD[(size_t)item * 128 + F.tid] = __expf(LB[63 * 128 + F.tid]);
      const bf16* qp = PROJ + (row0 + j) * LDP + C_QL + h * 128 + d0;
      const u32x4 q0 = hq0, q1 = hq1;
      const unsigned qw[8] = {q0.x, q0.y, q0.z, q0.w, q1.x, q1.y, q1.z, q1.w};
      unsigned qo[8], ko[8];
#pragma unroll
      for (int q = 0; q < 8; ++q) { const float l0 = LB[j * 128 + d0 + 2 * q], l1 = LB[j * 128 + d0 + 2 * q + 1];
          qo[q] = pk2(bflo(qw[q]) * 0.08838834764831845f * __expf(l0), bfhi(qw[q]) * 0.08838834764831845f * __expf(l1));
          ko[q] = pk2(bflo(xw[q]) * __expf(-l0), bfhi(xw[q]) * __expf(-l1)); }
      bf16* qd = QT + ((size_t)item * 64 + j) * 128 + d0; bf16* kd = KT + ((size_t)item * 64 + j) * 128 + d0;
      *(u32x4*)qd = (u32x4){qo[0], qo[1], qo[2], qo[3]}; *(u32x4*)(qd + 8) = (u32x4){qo[4], qo[5], qo[6], qo[7]};
      *(u32x4*)kd = (u32x4){ko[0], ko[1], ko[2], ko[3]}; *(u32x4*)(kd + 8) = (u32x4){ko[4], ko[5], ko[6], ko[7]}; }
    { const int j = F.tid >> 3, dv0 = (F.tid & 7) * 32; const bf16* vp = PROJ + (row0 + j) * LDP + C_VL + h * 256 + dv0;
      u32x4 x[4];
#pragma unroll
      for (int q = 0; q < 4; ++q) x[q] = hv[q];
#pragma unroll
      for (int q = 0; q < 4; ++q) { LAS bf16* o = Vt + (dv0 + q * 8) * 72 + j;
          o[0] = (bf16)(x[q].x & 0xffffu); o[72] = (bf16)(x[q].x >> 16); o[2 * 72] = (bf16)(x[q].y & 0xffffu); o[3 * 72] = (bf16)(x[q].y >> 16);
          o[4 * 72] = (bf16)(x[q].z & 0xffffu); o[5 * 72] = (bf16)(x[q].z >> 16); o[6 * 72] = (bf16)(x[q].w & 0xffffu); o[7 * 72] = (bf16)(x[q].w >> 16); } }
    __syncthreads();
#pragma unroll
    for (int i = 0; i < 4; ++i) { const int idx = F.tid + NT * i, dv = idx >> 3, ch = idx & 7;
        *(u32x4*)(VTG + ((size_t)item * 256 + dv) * 64 + ch * 8) = *(const LAS u32x4*)(Vt + dv * 72 + ch * 8); }
    const int r = F.lane & 15, quad = F.lane >> 4;
#pragma unroll 1
    for (int hf = 0; hf < 2; ++hf) {
        f32x4 acc[8];
#pragma unroll
        for (int i = 0; i < 8; ++i) acc[i] = (f32x4){0.f, 0.f, 0.f, 0.f};
#pragma unroll
        for (int ks = 0; ks < 2; ++ks) { const bf16x8 a = *(const LAS bf16x8*)(KH + (F.wave * 16 + r) * 72 + ks * 32 + quad * 8);
#pragma unroll
            for (int nt = 0; nt < 8; ++nt) { const bf16x8 bb = *(const LAS bf16x8*)(Vt + ((hf * 8 + nt) * 16 + r) * 72 + ks * 32 + quad * 8); acc[nt] = MFMA16(a, bb, acc[nt]); } }
#pragma unroll
        for (int nt = 0; nt < 8; ++nt) { u32x2 o; o.x = pk2(acc[nt][0], acc[nt][1]); o.y = pk2(acc[nt][2], acc[nt][3]);
            *(u32x2*)(UT + ((size_t)item * 256 + (hf * 8 + nt) * 16 + r) * 128 + F.wave * 16 + quad * 4) = o; }
    }
    __syncthreads();
}
DI void gla_scan(const Frame& F, bf16* UT, const float* GD) {
    const int total = 16 * 8192;
    for (int e = F.bid * NT + F.tid; e < total; e += F.G * NT) {
        const int bh = e >> 13, q = e & 8191, dv = q >> 5, d4 = (q & 31) * 4;
        bf16* p = UT + ((size_t)(bh * 128) * 256 + dv) * 128 + d4; const float* gp = GD + (size_t)(bh * 128) * 128 + d4;
        f32x4 s = (f32x4){0.f, 0.f, 0.f, 0.f};
        for (int c0 = 0; c0 < 128; c0 += 8) {
            u32x2 u[8]; f32x4 g[8];
#pragma unroll
            for (int i = 0; i < 8; ++i) { u[i] = *(const u32x2*)(p + (size_t)(c0 + i) * 32768); g[i] = *(const f32x4*)(gp + (size_t)(c0 + i) * 128); }
#pragma unroll
            for (int i = 0; i < 8; ++i) { u32x2 o; o.x = pk2(s.x, s.y); o.y = pk2(s.z, s.w); *(u32x2*)(p + (size_t)(c0 + i) * 32768) = o;
                s.x = g[i].x * s.x + bflo(u[i].x); s.y = g[i].y * s.y + bfhi(u[i].x); s.z = g[i].z * s.z + bflo(u[i].y); s.w = g[i].w * s.w + bfhi(u[i].y); }
        }
    }
}
DI void gla_c2_task(int item, int ip, int lane, const bf16* QT, const bf16* KT, const bf16* VTG, const bf16* ST, const bf16* PROJ, const float* g_out, bf16* MIX) {
    const int c = item & 127, h = (item >> 7) & 3, b = item >> 9;
    const int r = lane & 15, quad = lane >> 4;
    const bf16* qb = QT + (size_t)item * 64 * 128; const bf16* kb = KT + (size_t)item * 64 * 128;
    const bf16* vb = VTG + (size_t)item * 256 * 64; const bf16* sb = ST + (size_t)item * 256 * 128;
    const int it1 = 2 * ip + 1;
    bf16x8 Qf[2][4];
#pragma unroll
    for (int e = 0; e < 2; ++e)
#pragma unroll
        for (int ks = 0; ks < 4; ++ks) Qf[e][ks] = *(const bf16x8*)(qb + ((2 * ip + e) * 16 + r) * 128 + ks * 32 + quad * 8);
    f32x4 S[2][4];
    {
        bf16x8 ka[16];
#pragma unroll
        for (int jt = 0; jt < 4; ++jt)
#pragma unroll
            for (int ks = 0; ks < 4; ++ks) ka[jt * 4 + ks] = *(const bf16x8*)(kb + (jt * 16 + r) * 128 + ks * 32 + quad * 8);
        __builtin_amdgcn_sched_barrier(0);
#pragma unroll
        for (int jt = 0; jt < 4; ++jt) { S[0][jt] = (f32x4){0.f, 0.f, 0.f, 0.f}; S[1][jt] = S[0][jt];
#pragma unroll
            for (int ks = 0; ks < 4; ++ks) { S[0][jt] = MFMA16(ka[jt * 4 + ks], Qf[0][ks], S[0][jt]); S[1][jt] = MFMA16(ka[jt * 4 + ks], Qf[1][ks], S[1][jt]); } }
        __builtin_amdgcn_sched_barrier(0);
    }
    bf16x8 pb[2][2];
#pragma unroll
    for (int e = 0; e < 2; ++e) { const int it = 2 * ip + e;
#pragma unroll
        for (int kk = 0; kk < 2; ++kk) { unsigned w[4];
#pragma unroll
            for (int t2 = 0; t2 < 2; ++t2) { const int jt = 2 * kk + t2; float v[4];
#pragma unroll
                for (int jj = 0; jj < 4; ++jj) v[jj] = (jt < it || (jt == it && quad * 4 + jj <= r)) ? S[e][jt][jj] : 0.f;
                w[2 * t2] = pk2(v[0], v[1]); w[2 * t2 + 1] = pk2(v[2], v[3]); }
            pb[e][kk] = __builtin_bit_cast(bf16x8, (u32x4){w[0], w[1], w[2], w[3]}); } }
    f32x4 o[2][16];
#pragma unroll
    for (int i = 0; i < 16; ++i) { o[0][i] = (f32x4){0.f, 0.f, 0.f, 0.f}; o[1][i] = o[0][i]; }
#pragma unroll
    for (int g = 0; g < 4; ++g) {
        bf16x8 sa[16];
#pragma unroll
        for (int q = 0; q < 4; ++q)
#pragma unroll
            for (int ks = 0; ks < 4; ++ks) sa[q * 4 + ks] = *(const bf16x8*)(sb + ((g * 4 + q) * 16 + r) * 128 + ks * 32 + quad * 8);
        __builtin_amdgcn_sched_barrier(0);
#pragma unroll
        for (int q = 0; q < 4; ++q)
#pragma unroll
            for (int ks = 0; ks < 4; ++ks) { o[0][g * 4 + q] = MFMA16(sa[q * 4 + ks], Qf[0][ks], o[0][g * 4 + q]); o[1][g * 4 + q] = MFMA16(sa[q * 4 + ks], Qf[1][ks], o[1][g * 4 + q]); }
        __builtin_amdgcn_sched_barrier(0);
    }
#pragma unroll
    for (int kk = 0; kk < 2; ++kk) {
        if (2 * kk <= it1) {
#pragma unroll
            for (int hh = 0; hh < 2; ++hh) {
                s16x4 vlo[8], vhi[8];
#pragma unroll
                for (int q = 0; q < 8; ++q) { const bf16* vp = vb + ((hh * 8 + q) * 16 + r) * 64 + kk * 32 + quad * 4; vlo[q] = *(const s16x4*)vp; vhi[q] = *(const s16x4*)(vp + 16); }
                __builtin_amdgcn_sched_barrier(0);
#pragma unroll
                for (int q = 0; q < 8; ++q) { const bf16x8 a = __builtin_shufflevector(vlo[q], vhi[q], 0, 1, 2, 3, 4, 5, 6, 7);
                    o[0][hh * 8 + q] = MFMA16(a, pb[0][kk], o[0][hh * 8 + q]); o[1][hh * 8 + q] = MFMA16(a, pb[1][kk], o[1][hh * 8 + q]); }
                __builtin_amdgcn_sched_barrier(0);
            }
        } }
#pragma unroll
    for (int e = 0; e < 2; ++e) {
        float ss = 0.f;
#pragma unroll
        for (int i = 0; i < 16; ++i) ss += (o[e][i][0] * o[e][i][0] + o[e][i][1] * o[e][i][1]) + (o[e][i][2] * o[e][i][2] + o[e][i][3] * o[e][i][3]);
        ss += __shfl_xor(ss, 16); ss += __shfl_xor(ss, 32);
        const float rstd = __builtin_amdgcn_rsqf(ss * (1.f / 256.f) + EPS);
        const size_t row = (size_t)b * T + (size_t)c * 64 + (2 * ip + e) * 16 + r;
#pragma unroll
        for (int hh = 0; hh < 2; ++hh) {
            u32x2 rv[8]; f32x4 gv[8];
#pragma unroll
            for (int q = 0; q < 8; ++q) { rv[q] = *(const u32x2*)(PROJ + row * LDP + C_RL + h * 256 + (hh * 8 + q) * 16 + quad * 4); gv[q] = *(const f32x4*)(g_out + (hh * 8 + q) * 16 + quad * 4); }
            __builtin_amdgcn_sched_barrier(0);
#pragma unroll
            for (int q = 0; q < 8; ++q) { const int i = hh * 8 + q, dv0 = i * 16 + quad * 4; const u32x2 rr = rv[q]; const f32x4 gg = gv[q];
                u32x2 w; w.x = pk2(o[e][i][0] * rstd * gg.x * silu_f(bflo(rr.x)), o[e][i][1] * rstd * gg.y * silu_f(bfhi(rr.x)));
                w.y = pk2(o[e][i][2] * rstd * gg.z * silu_f(bflo(rr.y)), o[e][i][3] * rstd * gg.w * silu_f(bfhi(rr.y)));
                *(u32x2*)(MIX + row * 2048 + 1024 + h * 256 + dv0) = w; }
            __builtin_amdgcn_sched_barrier(0);
        }
    }
}
constexpr float NEGF = -1e30f, MINIT = -1e4f;
constexpr int TILE_LDS = 32768;
DI int vswz(int dv) { return (dv & 7) ^ ((dv >> 3) & 1); }
DI void issue_k(const Frame& F, const bf16* src, unsigned ld, LAS unsigned char* buf) {
#pragma unroll
    for (int i = 0; i < 2; ++i) { const unsigned P = (unsigned)F.tid * 16u + i * 8192u, row = P >> 8, ch = ((P >> 4) & 15u) ^ (row & 15u);
        __builtin_amdgcn_global_load_lds((const unsigned*)(src + row * ld + ch * 8u), (LAS unsigned*)(buf + F.wave * 1024 + i * 8192), 16, 0, 0); }
}
DI void issue_v(const Frame& F, const bf16* src, unsigned ld, LAS unsigned char* buf) {
#pragma unroll
    for (int i = 0; i < 2; ++i) { const unsigned P = (unsigned)F.tid * 16u + i * 8192u, dv = P >> 7, ch = ((P >> 4) & 7u) ^ (unsigned)vswz((int)dv);
        __builtin_amdgcn_global_load_lds((const unsigned*)(src + dv * ld + ch * 8u), (LAS unsigned*)(buf + 16384 + F.wave * 1024 + i * 8192), 16, 0, 0); }
}
#define TILE_SYNC() do { asm volatile("s_waitcnt vmcnt(0)" ::: "memory"); __syncthreads(); } while (0)
DI bool tile_sync_far(float sl0, float sl1, float m0, float m1, float dn) { asm volatile("s_waitcnt vmcnt(0)" ::: "memory"); return __syncthreads_and((-sl0 * dn + 182.f < m0) && (-sl1 * dn + 182.f < m1)) != 0; }
#define TILE_SYNC_FAR(dn) tile_sync_far(sl0, sl1, m[0], m[1], (dn))
template <int MODE, bool EARLYV = false>
DI void flash_tile(const bool MASKED, const LAS unsigned char* buf, const bf16x8 (&Qf)[2][4], f32x4 (&O)[8][2], float (&m)[2], float (&l)[2],
                   float base0, float base1, float ks0, float ks1, int klo, int khi, int lane, LAS float* imp, int jb0, int tok0) {
    const int r = lane & 15, quad = lane >> 4;
    const int kx = (quad ^ r) & 3, kr2 = r >> 2;
    const int vs = vswz(r);
#pragma unroll 1
    for (int sub = 0; sub < 2; ++sub) {
        const LAS unsigned char* Kp = buf + (sub * 32 + r) * 256 + kx * 16;
        const float kq = (float)(sub * 32 + quad * 4);
        const float bq0 = base0 + ks0 * kq, bq1 = base1 + ks1 * kq;
        f32x4 S[2][2];
#pragma unroll
        for (int kt = 0; kt < 2; ++kt)
#pragma unroll
            for (int j = 0; j < 4; ++j) { S[kt][0][j] = ks0 * (float)(kt * 16 + j) + bq0; S[kt][1][j] = ks1 * (float)(kt * 16 + j) + bq1; }
        if (EARLYV) {
            bf16x8 ka[8];
#pragma unroll
            for (int kt = 0; kt < 2; ++kt)
#pragma unroll
                for (int ks = 0; ks < 4; ++ks) ka[kt * 4 + ks] = *(const LAS bf16x8*)(Kp + kt * 16 * 256 + ((ks ^ kr2) & 3) * 64);
            __builtin_amdgcn_sched_barrier(0);
#pragma unroll
            for (int kt = 0; kt < 2; ++kt)
#pragma unroll
                for (int ks = 0; ks < 4; ++ks) { S[kt][0] = MFMA16(ka[kt * 4 + ks], Qf[0][ks], S[kt][0]); S[kt][1] = MFMA16(ka[kt * 4 + ks], Qf[1][ks], S[kt][1]); }
            __builtin_amdgcn_sched_barrier(0);
        } else {
#pragma unroll
            for (int kt = 0; kt < 2; ++kt) {
                bf16x8 ka[4];
#pragma unroll
                for (int ks = 0; ks < 4; ++ks) ka[ks] = *(const LAS bf16x8*)(Kp + kt * 16 * 256 + ((ks ^ kr2) & 3) * 64);
                __builtin_amdgcn_sched_barrier(0);
#pragma unroll
                for (int ks = 0; ks < 4; ++ks) { S[kt][0] = MFMA16(ka[ks], Qf[0][ks], S[kt][0]); S[kt][1] = MFMA16(ka[ks], Qf[1][ks], S[kt][1]); }
                __builtin_amdgcn_sched_barrier(0);
            }
        }
        s16x4 vlo[8], vhi[8];
        if (MODE != 1 && EARLYV) {
            const LAS unsigned char* Vp = buf + 16384 + r * 128 + (quad & 1) * 8;
            const int c0 = ((sub * 4 + (quad >> 1)) ^ vs) * 16, c1 = ((sub * 4 + (quad >> 1) + 2) ^ vs) * 16;
#pragma unroll
            for (int dvt = 0; dvt < 8; ++dvt) { const LAS unsigned char* vp = Vp + dvt * 16 * 128; vlo[dvt] = *(const LAS s16x4*)(vp + c0); vhi[dvt] = *(const LAS s16x4*)(vp + c1); }
            __builtin_amdgcn_sched_barrier(0);
        }
        if (MASKED) {
            const unsigned span = (unsigned)(khi - klo);
#pragma unroll
            for (int kt = 0; kt < 2; ++kt)
#pragma unroll
                for (int j = 0; j < 4; ++j) { const bool ok = (khi >= klo) && (unsigned)(sub * 32 + kt * 16 + quad * 4 + j - klo) <= span;
                    S[kt][0][j] = ok ? S[kt][0][j] : NEGF; S[kt][1][j] = ok ? S[kt][1][j] : NEGF; }
        }
        if (MODE != 2) {
            const float mx0 = fmaxf(fmaxf(fmaxf(S[0][0][0], S[0][0][1]), fmaxf(S[0][0][2], S[0][0][3])), fmaxf(fmaxf(S[1][0][0], S[1][0][1]), fmaxf(S[1][0][2], S[1][0][3])));
            const float mx1 = fmaxf(fmaxf(fmaxf(S[0][1][0], S[0][1][1]), fmaxf(S[0][1][2], S[0][1][3])), fmaxf(fmaxf(S[1][1][0], S[1][1][1]), fmaxf(S[1][1][2], S[1][1][3])));
            if (__builtin_amdgcn_ballot_w64(mx0 > m[0] + 8.f || mx1 > m[1] + 8.f) != 0ull) {
                float q0 = fmaxf(mx0, __shfl_xor(mx0, 16)); q0 = fmaxf(q0, __shfl_xor(q0, 32));
                float q1 = fmaxf(mx1, __shfl_xor(mx1, 16)); q1 = fmaxf(q1, __shfl_xor(q1, 32));
                const float n0 = fmaxf(m[0], q0), n1 = fmaxf(m[1], q1);
                const float a0 = __builtin_amdgcn_exp2f(m[0] - n0), a1 = __builtin_amdgcn_exp2f(m[1] - n1);
                m[0] = n0; m[1] = n1; l[0] *= a0; l[1] *= a1;
                if (MODE == 0) {
#pragma unroll
                    for (int dvt = 0; dvt < 8; ++dvt) { O[dvt][0] *= a0; O[dvt][1] *= a1; } }
            }
        }
        float mn[2] = {m[0], m[1]};
#pragma unroll
        for (int rt = 0; rt < 2; ++rt) {
            const float scale = (MODE == 2) ? l[rt] : 1.f;
            float ps = 0.f;
#pragma unroll
            for (int kt = 0; kt < 2; ++kt)
#pragma unroll
                for (int j = 0; j < 4; ++j) { float p = __builtin_amdgcn_exp2f(S[kt][rt][j] - mn[rt]); if (MODE == 2) p *= scale; S[kt][rt][j] = p; ps += p; }
            if (MODE != 2) l[rt] += ps;
        }
        if (MODE == 2) {
#pragma unroll
            for (int kt = 0; kt < 2; ++kt) { f32x4 p4 = S[kt][0] + S[kt][1];
                p4[0] += __shfl_xor(p4[0], 8); p4[1] += __shfl_xor(p4[1], 8); p4[2] += __shfl_xor(p4[2], 8); p4[3] += __shfl_xor(p4[3], 8);
                if (r < 8) { const int jb = jb0 + sub * 8 + kt * 4 + quad; float* ip = (float*)(imp + (tok0 + r) * 129 + jb);
                    atomicAdd(ip, 2.f * (p4[0] + p4[1] + p4[2]) + p4[3]); if (jb + 1 < 128) atomicAdd(ip + 1, p4[3]); } }
        }
        if (MODE != 1) {
            bf16x8 pb[2];
#pragma unroll
            for (int rt = 0; rt < 2; ++rt) { u32x4 w; w.x = pk2(S[0][rt][0], S[0][rt][1]); w.y = pk2(S[0][rt][2], S[0][rt][3]);
                w.z = pk2(S[1][rt][0], S[1][rt][1]); w.w = pk2(S[1][rt][2], S[1][rt][3]); pb[rt] = __builtin_bit_cast(bf16x8, w); }
            __builtin_amdgcn_sched_barrier(0);
            if (!EARLYV) {
                const LAS unsigned char* Vp = buf + 16384 + r * 128 + (quad & 1) * 8;
                const int c0 = ((sub * 4 + (quad >> 1)) ^ vs) * 16, c1 = ((sub * 4 + (quad >> 1) + 2) ^ vs) * 16;
#pragma unroll
                for (int hv = 0; hv < 2; ++hv) {
                    s16x4 wlo[4], whi[4];
#pragma unroll
                    for (int q = 0; q < 4; ++q) { const LAS unsigned char* vp = Vp + (hv * 4 + q) * 16 * 128; wlo[q] = *(const LAS s16x4*)(vp + c0); whi[q] = *(const LAS s16x4*)(vp + c1); }
                    __builtin_amdgcn_sched_barrier(0);
#pragma unroll
                    for (int q = 0; q < 4; ++q) { const bf16x8 a = __builtin_shufflevector(wlo[q], whi[q], 0, 1, 2, 3, 4, 5, 6, 7);
                        O[hv * 4 + q][0] = MFMA16(a, pb[0], O[hv * 4 + q][0]); O[hv * 4 + q][1] = MFMA16(a, pb[1], O[hv * 4 + q][1]); }
                    __builtin_amdgcn_sched_barrier(0);
                }
            } else {
#pragma unroll
                for (int dvt = 0; dvt < 8; ++dvt) { const bf16x8 a = __builtin_shufflevector(vlo[dvt], vhi[dvt], 0, 1, 2, 3, 4, 5, 6, 7);
                    O[dvt][0] = MFMA16(a, pb[0], O[dvt][0]); O[dvt][1] = MFMA16(a, pb[1], O[dvt][1]); }
                __builtin_amdgcn_sched_barrier(0);
            }
        }
    }
}
DI void load_q_frags(const bf16* qp, const float* g, float scale, int quad, bf16x8 (&Qf)[4]) {
    u32x4 x[4]; float ss = 0.f;
#pragma unroll
    for (int ks = 0; ks < 4; ++ks) { x[ks] = *(const u32x4*)(qp + ks * 32 + quad * 8);
        const float a0 = bflo(x[ks].x), a1 = bfhi(x[ks].x), a2 = bflo(x[ks].y), a3 = bfhi(x[ks].y), a4 = bflo(x[ks].z), a5 = bfhi(x[ks].z), a6 = bflo(x[ks].w), a7 = bfhi(x[ks].w);
        ss += (a0 * a0 + a1 * a1) + (a2 * a2 + a3 * a3) + (a4 * a4 + a5 * a5) + (a6 * a6 + a7 * a7); }
    ss += __shfl_xor(ss, 16); ss += __shfl_xor(ss, 32);
    const float rs = __builtin_amdgcn_rsqf(ss * (1.f / 128.f) + EPS) * scale;
#pragma unroll
    for (int ks = 0; ks < 4; ++ks) { const f32x4 g0 = *(const f32x4*)(g + ks * 32 + quad * 8), g1 = *(const f32x4*)(g + ks * 32 + quad * 8 + 4);
        u32x4 w; w.x = pk2(bflo(x[ks].x) * rs * g0.x, bfhi(x[ks].x) * rs * g0.y); w.y = pk2(bflo(x[ks].y) * rs * g0.z, bfhi(x[ks].y) * rs * g0.w);
        w.z = pk2(bflo(x[ks].z) * rs * g1.x, bfhi(x[ks].z) * rs * g1.y); w.w = pk2(bflo(x[ks].w) * rs * g1.z, bfhi(x[ks].w) * rs * g1.w);
        Qf[ks] = __builtin_bit_cast(bf16x8, w); }
}
constexpr int NS_IMP = 65536, NS_SEL = 98560, NS_BF = 99584, NS_LIST = 100096, NS_NL = 100608;
constexpr float LOG2E = 1.4426950408889634f;
DI float quad_sum(float v) { v += __shfl_xor(v, 16); v += __shfl_xor(v, 32); return v; }

DI void nsa_item(const Frame& F0, int item, const bf16* PROJ, const bf16* KC, const bf16* VCT, const bf16* VST, const bf16* VWT,
                 const float* g_q, const float* b_gate, const float* g_out, bf16* MIX, float* NSAO) {
    Frame F = F0;
    { int t_ = F0.tid; asm volatile("" : "+v"(t_)); __builtin_assume(t_ >= 0 && t_ < NT); F.tid = t_; F.lane = t_ & 63; }
    const int c = 127 - (item >> 3), kvh = 1 - (item & 1), b = (item >> 1) & 3;
    const int lane = F.lane, r = lane & 15, quad = lane >> 4;
    LAS float* IMP = (LAS float*)(F.lds + NS_IMP); LAS unsigned* SEL = (LAS unsigned*)(F.lds + NS_SEL); LAS unsigned* BFL = (LAS unsigned*)(F.lds + NS_BF);
    LAS int* LIST = (LAS int*)(F.lds + NS_LIST); LAS int* NLp = (LAS int*)(F.lds + NS_NL);
    const int tok = 8 * F.wave + (r & 7), t = 64 * c + tok;
    const unsigned trow = (unsigned)(b * T + t);
    const int hd0 = kvh * 4 + (r >> 3), hd1 = hd0 + 2;
    const float sl0 = exp2f(-(float)(hd0 + 1)) * LOG2E, sl1 = exp2f(-(float)(hd1 + 1)) * LOG2E;
    bf16x8 Qf[2][4];
    load_q_frags(PROJ + (size_t)trow * LDP + C_Q + hd0 * 128, g_q, 0.08838834764831845f * LOG2E, quad, Qf[0]);
    __builtin_amdgcn_sched_barrier(0);
    load_q_frags(PROJ + (size_t)trow * LDP + C_Q + hd1 * 128, g_q, 0.08838834764831845f * LOG2E, quad, Qf[1]);
    __builtin_amdgcn_sched_barrier(0);
    unsigned gpk0, gpk1, gpk2;
    { float gl[6], gb[6];
#pragma unroll
      for (int br = 0; br < 3; ++br) { gl[br] = bf2f(PROJ[(size_t)trow * LDP + C_GATE + hd0 * 3 + br]); gl[3 + br] = bf2f(PROJ[(size_t)trow * LDP + C_GATE + hd1 * 3 + br]); gb[br] = b_gate[hd0 * 3 + br]; gb[3 + br] = b_gate[hd1 * 3 + br]; }
      __builtin_amdgcn_sched_barrier(0);
      float gg[6];
#pragma unroll
      for (int i = 0; i < 6; ++i) gg[i] = __builtin_amdgcn_rcpf(1.f + __expf(-(gl[i] + gb[i])));
      gpk0 = pk2(gg[0], gg[3]); gpk1 = pk2(gg[1], gg[4]); gpk2 = pk2(gg[2], gg[5]); }
#define NSA_GATE(rt, br) ((rt) ? bfhi((br) == 0 ? gpk0 : (br) == 1 ? gpk1 : gpk2) : bflo((br) == 0 ? gpk0 : (br) == 1 ? gpk1 : gpk2))
    f32x4 O[8][2]; float m[2], l[2];
    f32x4* oscb = (f32x4*)NSAO + ((size_t)(F.bid * NWAVES + F.wave) * 16) * 64;
#define osc(k) oscb[(unsigned)((k) * 64 + lane)]
#pragma unroll
    for (int i = 0; i < 8; ++i) { O[i][0] = (f32x4){0.f, 0.f, 0.f, 0.f}; O[i][1] = O[i][0]; }
    for (int i = F.tid; i < 64 * 129; i += NT) IMP[i] = 0.f;
    if (F.tid < 256) SEL[F.tid] = 0u;
    LAS unsigned char* const lds = F.lds;
    const bf16* kc = KC + (size_t)(b * 2 + kvh) * 512 * 128; const bf16* vct = VCT + (size_t)(b * 2 + kvh) * 128 * 512;
    const int nct = (4 * c + 3 + 63) >> 6;
    m[0] = MINIT; m[1] = MINIT; l[0] = 0.f; l[1] = 0.f;
    __syncthreads();
    issue_k(F, kc + (size_t)(nct - 1) * 64 * 128, 128, lds); TILE_SYNC();
    for (int kt = nct - 1, n = 0; kt >= 0; --kt, ++n) {
        LAS unsigned char* cur = lds + (n & 1) * TILE_LDS; LAS unsigned char* nxt = lds + ((n & 1) ^ 1) * TILE_LDS;
        if (kt > 0) issue_k(F, kc + (size_t)(kt - 1) * 64 * 128, 128, nxt);
        const float d0 = (float)(t - 16 * (kt * 64)) - 15.5f; const int khi = (t - 31 - 16 * (kt * 64)) >> 4;
        flash_tile<1, true>(kt * 64 + 63 > 4 * c - 2, cur, Qf, O, m, l, -sl0 * d0, -sl1 * d0, 16.f * sl0, 16.f * sl1, 0, khi < 63 ? khi : 63, lane, IMP, 0, 0);
        TILE_SYNC();
    }
#pragma unroll
    for (int rt = 0; rt < 2; ++rt) { const float lt = quad_sum(l[rt]); l[rt] = lt > 0.f ? 1.f / lt : 0.f; }
    issue_k(F, kc + (size_t)(nct - 1) * 64 * 128, 128, lds); issue_v(F, vct + (nct - 1) * 64, 512, lds); TILE_SYNC();
    for (int kt = nct - 1, n = 0; kt >= 0; --kt, ++n) {
        LAS unsigned char* cur = lds + (n & 1) * TILE_LDS; LAS unsigned char* nxt = lds + ((n & 1) ^ 1) * TILE_LDS;
        if (kt > 0) { issue_k(F, kc + (size_t)(kt - 1) * 64 * 128, 128, nxt); issue_v(F, vct + (kt - 1) * 64, 512, nxt); }
        const float d0 = (float)(t - 16 * (kt * 64)) - 15.5f; const int khi = (t - 31 - 16 * (kt * 64)) >> 4;
        flash_tile<2, true>(kt * 64 + 63 > 4 * c - 2, cur, Qf, O, m, l, -sl0 * d0, -sl1 * d0, 16.f * sl0, 16.f * sl1, 0, khi < 63 ? khi : 63, lane, IMP, kt * 16, 8 * F.wave);
        TILE_SYNC();
    }
    { const float g00 = NSA_GATE(0, 0), g10 = NSA_GATE(1, 0);
#pragma unroll
      for (int i = 0; i < 8; ++i) { osc(i * 2) = O[i][0] * g00; osc(i * 2 + 1) = O[i][1] * g10; O[i][0] = (f32x4){0.f, 0.f, 0.f, 0.f}; O[i][1] = O[i][0]; } }
#pragma unroll 1
    for (int rnd = 0; rnd < 2; ++rnd) {
        const int ts = rnd * 32 + (F.tid >> 4), part = F.tid & 15; unsigned bits = 0u;
        if (c >= 16) {
            unsigned key[8];
#pragma unroll
            for (int q = 0; q < 8; ++q) { const int jq = part * 8 + q; key[q] = (jq >= 1 && jq <= c - 2) ? __float_as_uint(IMP[ts * 129 + jq]) + 1u : 0u; }
            unsigned Tk = 0u;
#pragma unroll 1
            for (int bit = 30; bit >= 0; --bit) { const unsigned trial = Tk | (1u << bit); int cnt = 0;
#pragma unroll
                for (int q = 0; q < 8; ++q) cnt += key[q] >= trial ? 1 : 0;
                cnt += __shfl_xor(cnt, 1); cnt += __shfl_xor(cnt, 2); cnt += __shfl_xor(cnt, 4); cnt += __shfl_xor(cnt, 8);
                if (cnt >= 13) Tk = trial; }
            int gt = 0, eq = 0;
#pragma unroll
            for (int q = 0; q < 8; ++q) { gt += key[q] > Tk ? 1 : 0; eq += key[q] == Tk ? 1 : 0; }
            int gtt = gt; gtt += __shfl_xor(gtt, 1); gtt += __shfl_xor(gtt, 2); gtt += __shfl_xor(gtt, 4); gtt += __shfl_xor(gtt, 8);
            int pre = eq;
            { int v = __shfl_up(pre, 1, 16); if (part >= 1) pre += v; v = __shfl_up(pre, 2, 16); if (part >= 2) pre += v; v = __shfl_up(pre, 4, 16); if (part >= 4) pre += v; v = __shfl_up(pre, 8, 16); if (part >= 8) pre += v; }
            int run = pre - eq; const int need = 13 - gtt;
#pragma unroll
            for (int q = 0; q < 8; ++q) { const int jq = part * 8 + q; bool pick = key[q] > Tk;
                if (key[q] == Tk && Tk != 0u) { pick = run < need; ++run; }
                pick = pick || jq == 0 || jq == c || jq == c - 1; bits |= pick ? (1u << q) : 0u; }
        } else {
#pragma unroll
            for (int q = 0; q < 8; ++q) bits |= (part * 8 + q <= c) ? (1u << q) : 0u;
        }
        if (bits) atomicOr((unsigned*)(SEL + ts * 4 + (part >> 2)), bits << ((part & 3) * 8));
    }
    __syncthreads();
    if (F.tid < 128) { unsigned any = 0u; for (int k = 0; k < 64; ++k) any |= SEL[k * 4 + (F.tid >> 5)]; BFL[F.tid] = (any >> (F.tid & 31)) & 1u; }
    unsigned wm0, wm1, wm2, wm3;
    { unsigned x0 = SEL[tok * 4], x1 = SEL[tok * 4 + 1], x2 = SEL[tok * 4 + 2], x3 = SEL[tok * 4 + 3];
#pragma unroll
      for (int o = 1; o < 8; o <<= 1) { x0 |= __shfl_xor(x0, o); x1 |= __shfl_xor(x1, o); x2 |= __shfl_xor(x2, o); x3 |= __shfl_xor(x3, o); }
      wm0 = __builtin_amdgcn_readfirstlane(x0); wm1 = __builtin_amdgcn_readfirstlane(x1); wm2 = __builtin_amdgcn_readfirstlane(x2); wm3 = __builtin_amdgcn_readfirstlane(x3); }
    __syncthreads();
    if (F.wave == 0) { const bool f0 = lane <= c && BFL[lane] != 0u, f1 = lane + 64 <= c && BFL[lane + 64] != 0u;
        const unsigned long long m0 = __builtin_amdgcn_ballot_w64(f0), m1 = __builtin_amdgcn_ballot_w64(f1), lt = (1ull << lane) - 1ull;
        if (f0) LIST[__builtin_popcountll(m0 & lt)] = lane;
        if (f1) LIST[__builtin_popcountll(m0) + __builtin_popcountll(m1 & lt)] = lane + 64;
        if (lane == 0) NLp[0] = __builtin_popcountll(m0) + __builtin_popcountll(m1); }
    __syncthreads();
    m[0] = MINIT; m[1] = MINIT; l[0] = 0.f; l[1] = 0.f;
    const bf16* ksb = PROJ + (size_t)b * T * LDP + C_KS + kvh * 128; const bf16* vsb = VST + (size_t)(b * 2 + kvh) * 128 * 8192;
    const int nl = NLp[0];
    { const int jb = LIST[nl - 1]; issue_k(F, ksb + (size_t)jb * 64 * LDP, LDP, lds); issue_v(F, vsb + (size_t)jb * 8192, 64, lds); }
    TILE_SYNC();
    for (int idx = nl - 1, n = 0; idx >= 0; --idx, ++n) {
        LAS unsigned char* cur = lds + (n & 1) * TILE_LDS; LAS unsigned char* nxt = lds + ((n & 1) ^ 1) * TILE_LDS;
        const int jb = LIST[idx];
        if (idx > 0) { const int jn = LIST[idx - 1]; issue_k(F, ksb + (size_t)jn * 64 * LDP, LDP, nxt); issue_v(F, vsb + (size_t)jn * 8192, 64, nxt); }
        const unsigned ww = jb < 32 ? wm0 : jb < 64 ? wm1 : jb < 96 ? wm2 : wm3;
        if ((ww >> (jb & 31)) & 1u) {
            const bool sel = ((SEL[tok * 4 + (jb >> 5)] >> (jb & 31)) & 1u) != 0u;
            const float d0 = (float)(t - jb * 64);
            const float b0 = sel ? -sl0 * d0 : NEGF, b1 = sel ? -sl1 * d0 : NEGF;
            flash_tile<0, true>(jb == c, cur, Qf, O, m, l, b0, b1, sl0, sl1, 0, tok, lane, IMP, 0, 0);
        }
        TILE_SYNC();
    }
#pragma unroll
    for (int rt = 0; rt < 2; ++rt) { const float lt = quad_sum(l[rt]); const float f = (lt > 0.f ? 1.f / lt : 0.f) * NSA_GATE(rt, 1);
        f32x4 tv[8];
#pragma unroll
        for (int i = 0; i < 8; ++i) tv[i] = osc(i * 2 + rt);
        __builtin_amdgcn_sched_barrier(0);
#pragma unroll
        for (int i = 0; i < 8; ++i) { osc(i * 2 + rt) = tv[i] + O[i][rt] * f; O[i][rt] = (f32x4){0.f, 0.f, 0.f, 0.f}; } }
    m[0] = MINIT; m[1] = MINIT; l[0] = 0.f; l[1] = 0.f;
    const bf16* kwb = PROJ + (size_t)b * T * LDP + C_KW + kvh * 128; const bf16* vwb = VWT + (size_t)(b * 2 + kvh) * 128 * 8192;
    const int jlo = c >= 8 ? c - 8 : 0;
    issue_k(F, kwb + (size_t)c * 64 * LDP, LDP, lds); issue_v(F, vwb + (size_t)c * 8192, 64, lds);
    TILE_SYNC();
    for (int jb = c, n = 0; jb >= jlo; --jb, ++n) {
        LAS unsigned char* cur = lds + (n & 1) * TILE_LDS; LAS unsigned char* nxt = lds + ((n & 1) ^ 1) * TILE_LDS;
        if (jb > jlo) { issue_k(F, kwb + (size_t)(jb - 1) * 64 * LDP, LDP, nxt); issue_v(F, vwb + (size_t)(jb - 1) * 8192, 64, nxt); }
        const int dd = t - jb * 64; const float d0 = (float)dd;
        flash_tile<0, true>(jb == c || jb == c - 8, cur, Qf, O, m, l, -sl0 * d0, -sl1 * d0, sl0, sl1, dd - 511 > 0 ? dd - 511 : 0, dd < 63 ? dd : 63, lane, IMP, 0, 0);
        TILE_SYNC();
    }
#pragma unroll
    for (int rt = 0; rt < 2; ++rt) { const float lt = quad_sum(l[rt]); const float f = (lt > 0.f ? 1.f / lt : 0.f) * NSA_GATE(rt, 2);
        f32x4 tv[8];
#pragma unroll
        for (int i = 0; i < 8; ++i) tv[i] = osc(i * 2 + rt);
        __builtin_amdgcn_sched_barrier(0);
#pragma unroll
        for (int i = 0; i < 8; ++i) O[i][rt] = tv[i] + O[i][rt] * f; }
    f32x4 gnv[8];
#pragma unroll
    for (int i = 0; i < 8; ++i) gnv[i] = *(const f32x4*)(g_out + i * 16 + quad * 4);
    __builtin_amdgcn_sched_barrier(0);
#pragma unroll
    for (int rt = 0; rt < 2; ++rt) { float ss = 0.f;
#pragma unroll
        for (int i = 0; i < 8; ++i) ss += (O[i][rt][0] * O[i][rt][0] + O[i][rt][1] * O[i][rt][1]) + (O[i][rt][2] * O[i][rt][2] + O[i][rt][3] * O[i][rt][3]);
        const float rstd = __builtin_amdgcn_rsqf(quad_sum(ss) * (1.f / 128.f) + EPS);
        const int hd = rt ? hd1 : hd0;
#pragma unroll
        for (int i = 0; i < 8; ++i) { const int dv0 = i * 16 + quad * 4; const f32x4 gg = gnv[i];
            u32x2 w; w.x = pk2(O[i][rt][0] * rstd * gg.x, O[i][rt][1] * rstd * gg.y); w.y = pk2(O[i][rt][2] * rstd * gg.z, O[i][rt][3] * rstd * gg.w);
            *(u32x2*)(MIX + (size_t)trow * 2048 + hd * 128 + dv0) = w; } }
    __syncthreads();
}

DI void cross_item(const Frame& F, int item, const bf16* CQ, const bf16* CKV, const bf16* CVT, const float* g_cq, bf16* CO) {
    const int tile = item & 31, h = (item >> 5) & 3, b = item >> 7;
    const int lane = F.lane, r = lane & 15, quad = lane >> 4;
    LAS unsigned char* const lds = F.lds;
    const size_t row0 = (size_t)b * T + tile * 256 + F.wave * 32 + r;
    bf16x8 Qf[2][4];
    load_q_frags(CQ + row0 * 512 + h * 128, g_cq, 0.08838834764831845f * LOG2E, quad, Qf[0]);
    load_q_frags(CQ + (row0 + 16) * 512 + h * 128, g_cq, 0.08838834764831845f * LOG2E, quad, Qf[1]);
    f32x4 O[8][2]; float m[2] = {MINIT, MINIT}, l[2] = {0.f, 0.f};
#pragma unroll
    for (int i = 0; i < 8; ++i) { O[i][0] = (f32x4){0.f, 0.f, 0.f, 0.f}; O[i][1] = O[i][0]; }
    const bf16* kb = CKV + (size_t)b * 256 * 1024 + h * 128; const bf16* vb = CVT + (size_t)(b * 4 + h) * 128 * 256;
    issue_k(F, kb, 1024, lds); issue_v(F, vb, 256, lds); TILE_SYNC();
    for (int kt = 0; kt < 4; ++kt) {
        LAS unsigned char* cur = lds + (kt & 1) * TILE_LDS; LAS unsigned char* nxt = lds + ((kt & 1) ^ 1) * TILE_LDS;
        if (kt < 3) { issue_k(F, kb + (size_t)(kt + 1) * 64 * 1024, 1024, nxt); issue_v(F, vb + (kt + 1) * 64, 256, nxt); }
        flash_tile<0, true>(false, cur, Qf, O, m, l, 0.f, 0.f, 0.f, 0.f, 0, 63, lane, (LAS float*)nullptr, 0, 0);
        TILE_SYNC();
    }
#pragma unroll
    for (int rt = 0; rt < 2; ++rt) { const float lt = quad_sum(l[rt]); const float f = lt > 0.f ? 1.f / lt : 0.f;
#pragma unroll
        for (int i = 0; i < 8; ++i) { u32x2 w; w.x = pk2(O[i][rt][0] * f, O[i][rt][1] * f); w.y = pk2(O[i][rt][2] * f, O[i][rt][3] * f);
            *(u32x2*)(CO + (row0 + rt * 16) * 512 + h * 128 + i * 16 + quad * 4) = w; } }
    __syncthreads();
}
struct Args { const float* in[31]; float* out; unsigned char* ws; int ph_lo, ph_hi; };
enum { I_X = 0, I_MEM, I_GMIX, I_WIN, I_BGATE, I_GQ, I_GKC, I_GKS, I_GKW, I_PEK, I_PEV, I_WCK1, I_WCK2, I_WCV1, I_WCV2, I_GNSA, I_WGK2, I_BGK, I_GGLA, I_WOUT,
       I_GCROSS, I_GMEM, I_WCQ, I_WCK, I_WCV, I_GCQ, I_GCK, I_WCO, I_GFFN, I_WGU, I_WDOWN };
constexpr int NPHASE = 13;
#define XB_TMO      128
#define XB_XCNT(j)  (256  + 64 * (j))
#define XB_XSUB(j)  (1280 + 64 * (j))
#define XB_XGEN(j)  (2304 + 64 * (j))
#define XB_TOP      3328
#define XB_TOPGEN   3392
#define XCD_BAR_WORDS 3456
#define XB_SPIN_CAP (1u << 18)

__device__ __forceinline__ unsigned xb_ld(unsigned* p)              { return __hip_atomic_load(p, __ATOMIC_RELAXED, __HIP_MEMORY_SCOPE_AGENT); }
__device__ __forceinline__ unsigned xb_add(unsigned* p, unsigned v) { return __hip_atomic_fetch_add(p, v, __ATOMIC_RELAXED, __HIP_MEMORY_SCOPE_AGENT); }
__device__ __forceinline__ unsigned xb_xcc_id() { return (unsigned)__builtin_amdgcn_s_getreg((3 << 11) | 20) & 0xFu; }
#define XB_SPIN(cond, bar) do { unsigned _sp = 0; while (cond) { __builtin_amdgcn_s_sleep(1); \
    if ((++_sp & 255u) == 0u) { if (xb_ld(&(bar)[XB_TMO])) break; if (_sp > XB_SPIN_CAP) { atomicAdd(&(bar)[XB_TMO], 1u); break; } } } } while (0)

struct XcdBarrier {
    unsigned* bar; unsigned x;
    volatile LAS unsigned* st;
};

__device__ __forceinline__ XcdBarrier xcd_barrier_post(unsigned* bar, volatile LAS unsigned* st, int tid) {
    XcdBarrier b; b.bar = bar; b.x = xb_xcc_id(); b.st = st;
    if (tid == 0) (void)xb_add(&bar[XB_XCNT(b.x)], 1u);
    return b;
}
__device__ __forceinline__ void xcd_barrier_complete(unsigned* bar, unsigned x, unsigned& nloc, unsigned& nx) {
    const unsigned G = gridDim.x * gridDim.y * gridDim.z;
    unsigned sum, cnt, mine, sp = 0u;
    for (;;) {
        sum = 0u; cnt = 0u; mine = 0u;
#pragma unroll
        for (unsigned j = 0; j < 16; ++j) { const unsigned c = xb_ld(&bar[XB_XCNT(j)]); sum += c; cnt += (c > 0u) ? 1u : 0u; mine = (j == x) ? c : mine; }
        if (sum == G) break;
        __builtin_amdgcn_s_sleep(1);
        if ((++sp & 255u) == 0u) { if (xb_ld(&bar[XB_TMO])) break; if (sp > XB_SPIN_CAP) { atomicAdd(&bar[XB_TMO], 1u); break; } }
    }
    nloc = mine > 0u ? mine : 1u; nx = cnt > 0u ? cnt : 1u;
}

__device__ __forceinline__ void xcd_barrier(const XcdBarrier& b, int tid) {
    asm volatile("s_waitcnt vmcnt(0)" ::: "memory");
    __syncthreads();
    if (tid == 0) {
        unsigned* bar = b.bar;
        __builtin_amdgcn_s_waitcnt(0);
        unsigned nloc = b.st[0], nx = b.st[1];
        if (nloc == 0u) { xcd_barrier_complete(bar, b.x, nloc, nx); b.st[0] = nloc; b.st[1] = nx; }
        const unsigned old = xb_add(&bar[XB_XSUB(b.x)], 1u);
        const unsigned gen = old / nloc;
        if (old + 1u == (gen + 1u) * nloc) {
            __builtin_amdgcn_fence(__ATOMIC_RELEASE, "agent");
            asm volatile("s_waitcnt vmcnt(0)" ::: "memory");
            const unsigned og = xb_add(&bar[XB_TOP], 1u);
            const unsigned tg = og / nx;
            if (og + 1u == (tg + 1u) * nx) xb_add(&bar[XB_TOPGEN], 1u);
            else XB_SPIN(xb_ld(&bar[XB_TOPGEN]) == tg, bar);
            __builtin_amdgcn_fence(__ATOMIC_ACQUIRE, "agent");
            xb_add(&bar[XB_XGEN(b.x)], 1u);
            asm volatile("s_waitcnt vmcnt(0)" ::: "memory");
        } else {
            XB_SPIN(xb_ld(&bar[XB_XGEN(b.x)]) == gen, bar);
            __builtin_amdgcn_fence(__ATOMIC_ACQUIRE, "agent");
            asm volatile("s_waitcnt vmcnt(0)" ::: "memory");
        }
    }
    __syncthreads();
}

DI void grid_bar(unsigned* bar, unsigned target, int tid) {
    asm volatile("s_waitcnt vmcnt(0)" ::: "memory");
    __syncthreads();
    if (tid == 0) {
        __builtin_amdgcn_fence(__ATOMIC_RELEASE, "agent");
        asm volatile("s_waitcnt vmcnt(0)" ::: "memory");
        __hip_atomic_fetch_add(bar, 1u, __ATOMIC_RELAXED, __HIP_MEMORY_SCOPE_AGENT);
        while (__hip_atomic_load(bar, __ATOMIC_RELAXED, __HIP_MEMORY_SCOPE_AGENT) < target) __builtin_amdgcn_s_sleep(2);
        __builtin_amdgcn_fence(__ATOMIC_ACQUIRE, "agent");
        asm volatile("s_waitcnt vmcnt(0)" ::: "memory");
    }
    __syncthreads();
}
DI int next_item(unsigned* ctr, LAS int* slot, int tid) {
    __syncthreads();
    if (tid == 0) *slot = (int)__hip_atomic_fetch_add(ctr, 1u, __ATOMIC_RELAXED, __HIP_MEMORY_SCOPE_AGENT);
    __syncthreads();
    return *slot;
}
#define CTR(k) ((unsigned*)(AWS + WS_BAR) + 16 * (k))
#define SLOT ((LAS int*)(F.lds + LDS_BYTES - 64))
typedef const __attribute__((address_space(4))) Args* KArgsP;
DI KArgsP kargs() { auto p = __builtin_amdgcn_kernarg_segment_ptr(); asm volatile("" : "+s"(p)); return (KArgsP)p; }
#define AIN(k) ((const float*)kargs()->in[k])
#define AOUT ((float*)kargs()->out)
#define AWS ((unsigned char*)kargs()->ws)
__global__ void __launch_bounds__(NT, 2) mega(Args a) {
    extern __shared__ __attribute__((aligned(16))) unsigned char lds_raw[];
    cg::grid_group grid = cg::this_grid();
    Frame F; F.lds = (LAS unsigned char*)lds_raw; F.tid = threadIdx.x; F.lane = F.tid & 63; F.wave = __builtin_amdgcn_readfirstlane(F.tid >> 6);
    F.G = gridDim.x; F.bid = blockIdx.x; F.in = nullptr;
    ((LAS int*)(F.lds + LDS_BYTES - 4096))[F.tid] = F.tid;
    __syncthreads();
#define WT_IN ((bf16*)(AWS + WS_WT_IN))
#define WT_OUT ((bf16*)(AWS + WS_WT_OUT))
#define WT_CQ ((bf16*)(AWS + WS_WT_CQ))
#define WT_CKV ((bf16*)(AWS + WS_WT_CKV))
#define WT_CO ((bf16*)(AWS + WS_WT_CO))
#define WT_GU ((bf16*)(AWS + WS_WT_GU))
#define WT_DOWN ((bf16*)(AWS + WS_WT_DOWN))
#define WT_C1K ((bf16*)(AWS + WS_WT_C1K))
#define WT_C1V ((bf16*)(AWS + WS_WT_C1V))
#define WT_C2K ((bf16*)(AWS + WS_WT_C2K))
#define WT_C2V ((bf16*)(AWS + WS_WT_C2V))
#define HM ((bf16*)(AWS + WS_HM))
#define CKV ((bf16*)(AWS + WS_CKV))
#define CVT ((bf16*)(AWS + WS_CVT))
#define KC ((bf16*)(AWS + WS_KC))
#define VCT ((bf16*)(AWS + WS_VCT))
#define VST ((bf16*)(AWS + WS_VST))
#define VWT ((bf16*)(AWS + WS_VWT))
#define CQ ((bf16*)(AWS + WS_CQ))
#define CO ((bf16*)(AWS + WS_CO))
#define H ((bf16*)(AWS + WS_H))
#define MIX ((bf16*)(AWS + WS_MIX))
#define UT ((bf16*)(AWS + WS_UT))
#define PROJ ((bf16*)(AWS + WS_PROJ))
#define HID ((bf16*)(AWS + WS_HID))
#define GD ((float*)(AWS + WS_GD))
    const int lo = a.ph_lo, hi = a.ph_hi;
    if (hi > 1000) grid.sync();
    { volatile LAS unsigned* st_ = (volatile LAS unsigned*)(F.lds + LDS_BYTES - 128); if (F.tid < 2) st_[F.tid] = 0u; }
    __syncthreads();
    const unsigned xcc_id_ = xcd_barrier_post((unsigned*)(AWS + WS_BAR + 4096), (volatile LAS unsigned*)(F.lds + LDS_BYTES - 128), F.tid).x;
#ifndef PHM
#define PHM 0x1fff
#endif
#define IN(k) (((PHM >> (k)) & 1) && lo <= (k) && (k) < hi)
#ifndef RPT
#define RPT 0
#endif
#define NREP(k) (1 + ((RPT >> (k)) & 1))
#define SEAM(k) do { if ((k) + 1 < hi) { XcdBarrier xb_; xb_.bar = (unsigned*)(AWS + WS_BAR + 4096); xb_.x = xcc_id_; xb_.st = (volatile LAS unsigned*)(F.lds + LDS_BYTES - 128); xcd_barrier(xb_, F.tid); } } while (0)

#define REPEAT(k) for (int rep = 0; rep < NREP(k); ++rep)
#define REFRESH() do { int l_; asm volatile("v_mbcnt_lo_u32_b32 %0, -1, 0\n\tv_mbcnt_hi_u32_b32 %0, -1, %0" : "=v"(l_)); int t_ = ((LAS int*)(F.lds + LDS_BYTES - 4096))[F.wave * 64 + l_]; __builtin_assume(t_ >= 0 && t_ < NT); F.tid = t_; F.lane = t_ & 63; } while (0)
#define KILL() do { F.tid = 0; F.lane = 0; } while (0)
#define XB H
    KILL(); if (IN(0)) { REFRESH();
        REPEAT(0) {
        LAS float* scr = (LAS float*)(F.lds + F.wave * 16384);
        const int gw = F.bid * NWAVES + F.wave, NGW = F.G * NWAVES;
        constexpr int NITEMS = 32 * 184 + 2 * 32 * 16 + 2 * 64 * 8 + 2 * 4 * 4;
        for (int it = gw; it < NITEMS; it += NGW) { int r = it;
            if (transpose_mat(r, AIN(I_WIN), 2048, DIN, LDP, WT_IN, 0, 0, scr, F.lane)) continue;
            if (transpose_mat(r, AIN(I_WCK), 2048, 512, 512, WT_CKV, 0, 0, scr, F.lane)) continue;
            if (transpose_mat(r, AIN(I_WCV), 2048, 512, 512, WT_CKV, 512, 0, scr, F.lane)) continue;
            if (transpose_mat(r, AIN(I_WCK1), 4096, 256, 256, WT_C1K, 0, 0, scr, F.lane)) continue;
            if (transpose_mat(r, AIN(I_WCV1), 4096, 256, 256, WT_C1V, 0, 0, scr, F.lane)) continue;
            if (transpose_mat(r, AIN(I_WCK2), 256, 128, 128, WT_C2K, 0, 0, scr, F.lane)) continue;
            transpose_mat(r, AIN(I_WCV2), 256, 128, 128, WT_C2V, 0, 0, scr, F.lane);
        }
        rms_rows_phase(F, AIN(I_X), AIN(I_GMIX), H, M);
        rms_rows_phase(F, AIN(I_MEM), AIN(I_GMEM), HM, MM);
        { float* z = (float*)(AWS + WS_SS1); for (int i = F.bid * NT + F.tid; i < 2 * 65536; i += F.G * NT) z[i] = 0.f; }
        }
        SEAM(0);
    }
#ifdef XBAR
    for (int xb = 0; xb < XBAR; ++xb) { bar_target += (unsigned)F.G; grid_bar((unsigned*)(AWS + WS_BAR), bar_target, F.tid); }
#endif
    KILL(); if (IN(1)) { REFRESH();
        REPEAT(1) {
        { pg8::Gemm g{H, WT_IN, M, LDP, 2048}; pg8::StaticOrder S; S.init(M, LDP, F.G, F.bid); pg8::EpiBf16 E{PROJ, LDP, nullptr};
          pg8::gemm_phase<pg8::EpiBf16, pg8::StaticOrder, true, true>(F.lds, g, S, E, F.tid); }
        { pg8::Gemm g{HM, WT_CKV, MM, 1024, 2048}; pg8::StaticOrder S; S.init(MM, 1024, F.G, (F.bid + 16) % F.G); pg8::EpiBf16 E{CKV, 1024, nullptr};
          pg8::gemm_phase<pg8::EpiBf16, pg8::StaticOrder, true, true>(F.lds, g, S, E, F.tid); }
        }
        SEAM(1);
    }
    KILL(); if (IN(2)) { REFRESH();
        REPEAT(2) {
        for (int it = next_item(CTR(1 + 4 * rep), SLOT, F.tid); it < 256 + 512 + 16 + 2048; it = next_item(CTR(1 + 4 * rep), SLOT, F.tid)) {
            if (it < 256) compress_item(F, it, PROJ, AIN(I_PEK), AIN(I_PEV), WT_C1K, WT_C1V, WT_C2K, WT_C2V, AIN(I_GKC), KC, VCT);
            else if (it < 768) { if (rep) continue; const int i = it - 256, b = i >> 7, blk = i & 127;
                prep_item(F, PROJ, LDP, b * T + blk * 64, C_KS, C_VS, 512, AIN(I_GKS), AIN(I_GKW), VST + ((size_t)(b * 2) * 128 + blk) * 8192, (size_t)128 * 8192, (WS_VWT - WS_VST) / 2, 64, 0); }
            else if (it < 784) { if (rep) continue; const int i = it - 768, b = i >> 2, mb = i & 3;
                prep_item(F, CKV, 1024, b * 256 + mb * 64, 0, 512, 256, AIN(I_GCK), AIN(I_GCK), CVT + (size_t)(b * 4) * 128 * 256, (size_t)128 * 256, (size_t)2 * 128 * 256, 256, mb * 64); }
            else gla_a_item(F, it - 784, PROJ, AIN(I_WGK2), AIN(I_BGK), UT, GD, CQ, CO, H);
        }
        }
        SEAM(2);
    }
    KILL(); if (IN(3)) { REFRESH();
        REPEAT(3) {
        if (rep == 0) { gla_scan(F, UT, GD);
            asm volatile("s_waitcnt vmcnt(0)" ::: "memory"); __syncthreads();
            if (F.tid == 0) { __builtin_amdgcn_fence(__ATOMIC_RELEASE, "agent"); asm volatile("s_waitcnt vmcnt(0)" ::: "memory"); __hip_atomic_fetch_add(CTR(12), 1u, __ATOMIC_RELAXED, __HIP_MEMORY_SCOPE_AGENT); } }
        { const int xcc = (int)(__builtin_amdgcn_s_getreg((3 << 11) | 20) & 7u);
          for (int k = 0; k < 8;) { const int q = (xcc + k) & 7;
              const int i = next_item((unsigned*)(AWS + WS_BAR) + 256 + 16 * q, SLOT, F.tid);
              if (i >= 128) { ++k; continue; }
              nsa_item(F, i * 8 + q, PROJ, KC, VCT, VST, VWT, AIN(I_GQ), AIN(I_BGATE), AIN(I_GNSA), MIX, (float*)(AWS + WS_NSAO)); } }
        int it = next_item(CTR(2 + 4 * rep), SLOT, F.tid) + 1024;
        it = __builtin_amdgcn_readfirstlane(it);
        if (it < 1024 + 512) {
            if (F.tid == 0) { while (__hip_atomic_load(CTR(12), __ATOMIC_RELAXED, __HIP_MEMORY_SCOPE_AGENT) < (unsigned)F.G) __builtin_amdgcn_s_sleep(2);
                __builtin_amdgcn_fence(__ATOMIC_ACQUIRE, "agent"); asm volatile("s_waitcnt vmcnt(0)" ::: "memory"); }
            __syncthreads();
        }
        for (; it < 1024 + 512; it = next_item(CTR(2 + 4 * rep), SLOT, F.tid) + 1024) { const int task = (it - 1024) * 8 + F.wave;
            gla_c2_task(task >> 1, (task + (task >> 11)) & 1, F.lane, CQ, CO, H, UT, PROJ, AIN(I_GGLA), MIX); }
        constexpr int NLATE = (32 * 64 + 32 * 16 + 8 * 64 + 32 * 352 + 88 * 64) / 8;
        if (rep == 0) for (int it = next_item(CTR(5), SLOT, F.tid); it < NLATE; it = next_item(CTR(5), SLOT, F.tid)) {
            LAS float* scr = (LAS float*)(F.lds + F.wave * 16384); int r = it * 8 + F.wave;
            if (transpose_mat(r, AIN(I_WOUT), 2048, 2048, 2048, WT_OUT, 0, 0, scr, F.lane)) continue;
            if (transpose_mat(r, AIN(I_WCQ), 2048, 512, 512, WT_CQ, 0, 0, scr, F.lane, AIN(I_GCROSS))) continue;
            if (transpose_mat(r, AIN(I_WCO), 512, 2048, 2048, WT_CO, 0, 0, scr, F.lane)) continue;
            if (transpose_mat(r, AIN(I_WGU), 2048, 2 * DFF, 2 * DFF, WT_GU, 0, 1, scr, F.lane, AIN(I_GFFN))) continue;
            transpose_mat(r, AIN(I_WDOWN), DFF, 2048, 2048, WT_DOWN, 0, 0, scr, F.lane);
        }
        }
        SEAM(3);
    }
    KILL(); if (IN(5)) { REFRESH();
        pg8::Gemm g{MIX, WT_OUT, M, 2048, 2048}; pg8::StaticOrder S; S.init(M, 2048, F.G, F.bid); pg8::EpiResSS<true> E{AIN(I_X), XB, (float*)(AWS + WS_SS1), 2048};
        pg8::gemm_phase<pg8::EpiResSS<true>, pg8::StaticOrder, true, true>(F.lds, g, S, E, F.tid);
        SEAM(5);
    }
    KILL(); if (IN(7)) { REFRESH();
        pg8::Gemm g{XB, WT_CQ, M, 512, 2048}; pg8::StaticOrder S; S.init(M, 512, F.G, F.bid); pg8::EpiBf16 E{CQ, 512, (const float*)(AWS + WS_SS1)};
        pg8::gemm_phase<pg8::EpiBf16, pg8::StaticOrder, true, true>(F.lds, g, S, E, F.tid);
        if (F.G == 256) {
            pg8::Unit u; S.next(0, u);
            asm volatile("s_waitcnt vmcnt(0)" ::: "memory"); __syncthreads();
            for (int e = 0; e < 2; ++e) cross_item(F, ((u.pm >> 5) << 7) | ((2 * u.pn + e) << 5) | (u.pm & 31), CQ, CKV, CVT, AIN(I_GCQ), CO);
        } else { SEAM(7); }
    }
    KILL(); if (IN(8)) { REFRESH();
        if (F.G != 256) { for (int it = next_item(CTR(4), SLOT, F.tid); it < 512; it = next_item(CTR(4), SLOT, F.tid)) cross_item(F, it, CQ, CKV, CVT, AIN(I_GCQ), CO); }
        SEAM(8); }
    KILL(); if (IN(9)) { REFRESH();
        pg8::Gemm g{CO, WT_CO, M, 2048, 512}; pg8::StaticOrder S; S.init(M, 2048, F.G, F.bid); pg8::EpiResSS<false> E{XB, XB, (float*)(AWS + WS_SS2), 2048};
        pg8::gemm_phase<pg8::EpiResSS<false>, pg8::StaticOrder, true, true>(F.lds, g, S, E, F.tid);
        SEAM(9);
    }
    KILL(); if (IN(11)) { REFRESH();
        REPEAT(11) {
        pg8::Gemm g{XB, WT_GU, M, 2 * DFF, 2048}; pg8::StaticOrder S; S.init(M, 2 * DFF, F.G, F.bid); pg8::EpiSwiGLU E{HID, DFF, (const float*)(AWS + WS_SS2)};
        pg8::gemm_phase<pg8::EpiSwiGLU, pg8::StaticOrder, true, true>(F.lds, g, S, E, F.tid);
        }
        SEAM(11);
    }
    KILL(); if (IN(12)) { REFRESH();
        pg8::Gemm g{HID, WT_DOWN, M, 2048, DFF}; pg8::StaticOrder S; S.init(M, 2048, F.G, F.bid); pg8::EpiOutF32 E{XB, AOUT, 2048};
        pg8::gemm_phase<pg8::EpiOutF32, pg8::StaticOrder, true, true>(F.lds, g, S, E, F.tid);
    }
#undef IN
#undef SEAM
}

extern "C" void kernel_launch(void* const* d_in, const int* in_sizes, int n_in, void* d_out, int out_size, void* d_ws, size_t ws_size, hipStream_t stream) {
    static int grid = 0;
    if (grid == 0) {
        if (n_in != 31 || out_size != M * D || ws_size < WS_END) { fprintf(stderr, "kernel_launch: unexpected shapes n_in %d out %d ws %zu\n", n_in, out_size, ws_size); grid = -1; return; }
        int dev = 0, cus = 0, per = 0;
        (void)hipGetDevice(&dev); (void)hipDeviceGetAttribute(&cus, hipDeviceAttributeMultiprocessorCount, dev);
        (void)hipFuncSetAttribute((const void*)mega, hipFuncAttributeMaxDynamicSharedMemorySize, LDS_BYTES);
        (void)hipOccupancyMaxActiveBlocksPerMultiprocessor(&per, (const void*)mega, NT, LDS_BYTES);
        if (per < 1) per = 1;
        grid = cus * per;
        fprintf(stderr, "kernel_launch: grid %d (%d CUs x %d)\n", grid, cus, per);
    }
    if (grid < 0) return;
    (void)hipMemsetAsync((char*)d_ws + WS_BAR, 0, 4096 + 16384, stream);
    Args a{};
    for (int i = 0; i < 31; ++i) a.in[i] = (const float*)d_in[i];
    a.out = (float*)d_out; a.ws = (unsigned char*)d_ws; a.ph_lo = 0; a.ph_hi = NPHASE;
    void* args[] = {&a};
    hipError_t e = hipLaunchCooperativeKernel((const void*)mega, dim3(grid), dim3(NT), args, LDS_BYTES, stream);
    if (e != hipSuccess) fprintf(stderr, "kernel_launch: cooperative launch failed: %s (grid %d)\n", hipGetErrorString(e), grid);
}
```
